# Optimizing an MI355X kernel written in HIP

```python
import jax, jax.numpy as jnp
from jax import lax
import numpy as np

D_MODEL = 2048
BATCH = 8
SEQ = 2048
DEPTH = 1

HEAD_DIM = 128
ATTN_HEADS = D_MODEL // HEAD_DIM
ATTN_WIDTH = ATTN_HEADS * HEAD_DIM
DILATION_PATTERNS = ((128, 1), (512, 4), (2048, 16))
ATTN_BLOCK = 128
ROPE_THETA = 500000.0
ROPE_DIM = HEAD_DIM // 4
POS_OFFSET_MAX = 4096

REC_EXPAND = 128
REC_HEADS = D_MODEL // REC_EXPAND
REC_KEY_DIM = REC_EXPAND
REC_VAL_DIM = D_MODEL // REC_HEADS
REC_WIDTH = REC_HEADS * REC_KEY_DIM
REC_VWIDTH = REC_HEADS * REC_VAL_DIM
REC_CHUNK = 64

IN_SECTIONS = (ATTN_WIDTH, ATTN_WIDTH, ATTN_WIDTH,
               REC_WIDTH, REC_WIDTH, REC_VWIDTH, REC_VWIDTH,
               D_MODEL, D_MODEL)
IN_WIDTH = sum(IN_SECTIONS)

N_GROUPS = 4
EXPERTS_PER_GROUP = 8
N_EXPERTS = N_GROUPS * EXPERTS_PER_GROUP
TOP_K = 2
EXPERT_HIDDEN = D_MODEL // 2
MOE_BLOCK = 128

NORM_EPS = 1e-6

kernel_name = "hybrid_dilated_attn_hgrn2_hiermoe_block"


def rms_norm(x, g):
    xf = x.astype(jnp.float32)
    y = xf * lax.rsqrt(jnp.mean(xf * xf, axis=-1, keepdims=True) + NORM_EPS)
    return (y * g.astype(jnp.float32)).astype(x.dtype)


def modulate(y, shift, scale):
    return y * (1 + scale[:, None, :]) + shift[:, None, :]


def partial_rotary(x, positions):
    half = ROPE_DIM // 2
    inv_freq = ROPE_THETA ** (-jnp.arange(0, ROPE_DIM, 2, dtype=jnp.float32) / ROPE_DIM)
    ang = positions.astype(jnp.float32)[..., None] * inv_freq
    cos, sin = jnp.cos(ang)[:, :, None, :], jnp.sin(ang)[:, :, None, :]
    xf = x.astype(jnp.float32)
    x1, x2, xp = xf[..., :half], xf[..., half:ROPE_DIM], xf[..., ROPE_DIM:]
    out = jnp.concatenate([x1 * cos - x2 * sin, x2 * cos + x1 * sin, xp], axis=-1)
    return out.astype(x.dtype)


def dilated_window_attention(q, k, v, window, dilation):
    B, S, H, Dh = q.shape
    span = window // dilation
    n_sub = S // dilation
    L = min(ATTN_BLOCK, n_sub)
    nb = -(-n_sub // L)
    tail = nb * L - n_sub
    BR = B * dilation

    def to_sub(a):
        a = a.reshape(B, n_sub, dilation, H, Dh)
        return jnp.swapaxes(a, 1, 2).reshape(BR, n_sub, H, Dh)

    def key_blocks(a):
        a = jnp.pad(to_sub(a), ((0, 0), (L, tail), (0, 0), (0, 0)))
        prev = a[:, :nb * L].reshape(BR, nb, L, H, Dh)
        cur = a[:, L:].reshape(BR, nb, L, H, Dh)
        return jnp.concatenate([prev, cur], axis=2)

    qs = jnp.pad(to_sub(q), ((0, 0), (0, tail), (0, 0), (0, 0))).reshape(BR, nb, L, H, Dh)
    kb, vb = key_blocks(k), key_blocks(v)

    qi = jnp.arange(L)[:, None]
    kj = jnp.arange(2 * L)[None, :]
    dist = qi - kj + L
    kpos = jnp.arange(nb)[:, None, None] * L + kj[None] - L
    valid = (dist >= 0)[None] & (dist <= span)[None] & (kpos >= 0)

    s = jnp.einsum('bnqhd,bnkhd->bnhqk', qs, kb).astype(jnp.float32) * (Dh ** -0.5)
    s = jnp.where(valid[None, :, None], s, -jnp.inf)
    m = jnp.max(s, axis=-1, keepdims=True)
    p = jnp.exp(s - m)
    den = jnp.sum(p, axis=-1, keepdims=True)
    o = jnp.einsum('bnhqk,bnkhd->bnqhd', p, vb.astype(jnp.float32)) / jnp.swapaxes(den, 2, 3)
    lse = jnp.swapaxes((m + jnp.log(den))[..., 0], 2, 3)

    def from_sub(a):
        trail = a.shape[3:]
        a = a.reshape((B, dilation, nb * L) + trail)[:, :, :n_sub]
        return jnp.swapaxes(a, 1, 2).reshape((B, S) + trail)

    return from_sub(o), from_sub(lse)


def dilated_mixture_attention(q, k, v):
    outs, lses = [], []
    for window, dilation in DILATION_PATTERNS:
        o, lse = dilated_window_attention(q, k, v, window, dilation)
        outs.append(o)
        lses.append(lse)
    alpha = jax.nn.softmax(jnp.stack(lses), axis=0)
    return jnp.einsum('pbsh,pbshd->bshd', alpha, jnp.stack(outs))


def chunked_gated_recurrence(q, k, v, log_f):
    B, S, H, K = q.shape
    V = v.shape[-1]
    C = min(REC_CHUNK, S)
    nc = S // C

    def to_chunks(a):
        return a.reshape(B, nc, C, H, a.shape[-1]).transpose(1, 0, 3, 2, 4)

    causal = jnp.tril(jnp.ones((C, C), dtype=bool))

    def step(state, blk):
        qb, kb, vb, gb = blk
        b = jnp.cumsum(gb, axis=2)
        rel = jnp.where(causal[:, :, None], b[:, :, :, None, :] - b[:, :, None, :, :], -jnp.inf)
        scores = jnp.einsum('bhtk,bhtsk,bhsk->bhts', qb, jnp.exp(rel), kb)
        intra = jnp.einsum('bhts,bhsv->bhtv', scores, vb)
        inter = jnp.einsum('bhtk,bhkv->bhtv', qb * jnp.exp(b), state)
        b_last = b[:, :, -1, :]
        new_state = jnp.exp(b_last)[..., None] * state + jnp.einsum(
            'bhsk,bhsv->bhkv', kb * jnp.exp(b_last[:, :, None, :] - b), vb)
        return new_state, intra + inter

    state0 = jnp.zeros((B, H, K, V), jnp.float32)
    _, out = lax.scan(step, state0, (to_chunks(q), to_chunks(k), to_chunks(v), to_chunks(log_f)))
    return out.transpose(1, 0, 3, 2, 4).reshape(B, S, H, V)


def hgrn2_branch(q_r, f_r, i_r, g_r, lower_bound, norm_g):
    B, S, _ = q_r.shape
    lb = lower_bound.reshape(REC_HEADS, REC_KEY_DIM)
    fpre = f_r.astype(jnp.float32).reshape(B, S, REC_HEADS, REC_KEY_DIM)
    log_f = jnp.log(lb + (1 - lb) * jax.nn.sigmoid(fpre))
    k = (1 - lb) * jax.nn.sigmoid(-fpre)
    q = jax.nn.silu(q_r.astype(jnp.float32)).reshape(B, S, REC_HEADS, REC_KEY_DIM)
    v = i_r.astype(jnp.float32).reshape(B, S, REC_HEADS, REC_VAL_DIM)
    o = chunked_gated_recurrence(q, k, v, log_f)
    gate = jax.nn.silu(g_r.astype(jnp.float32).reshape(B, S, REC_HEADS, REC_VAL_DIM))
    o = rms_norm(o, norm_g) * gate
    return o.reshape(B, S, REC_VWIDTH).astype(q_r.dtype)


def hybrid_mixer(u, positions, w_in, w_attn_branch, w_rec_branch, w_mix_out, rec_norm_g, lower_bound):
    B, S, _ = u.shape
    proj = u @ w_in
    splits = np.cumsum(IN_SECTIONS)[:-1].tolist()
    q_a, k_a, v_a, q_r, f_r, i_r, g_r, gate_a, gate_r = jnp.split(proj, splits, axis=-1)
    q_a = partial_rotary(q_a.reshape(B, S, ATTN_HEADS, HEAD_DIM), positions)
    k_a = partial_rotary(k_a.reshape(B, S, ATTN_HEADS, HEAD_DIM), positions)
    v_a = v_a.reshape(B, S, ATTN_HEADS, HEAD_DIM)
    y_attn = dilated_mixture_attention(q_a, k_a, v_a).reshape(B, S, ATTN_WIDTH).astype(u.dtype)
    y_rec = hgrn2_branch(q_r, f_r, i_r, g_r, lower_bound, rec_norm_g)
    merged = (jax.nn.sigmoid(gate_a) * (y_attn @ w_attn_branch)
              + jax.nn.sigmoid(gate_r) * (y_rec @ w_rec_branch))
    return merged @ w_mix_out


def hierarchical_route(xt, wg, bg, we, be):
    T = xt.shape[0]
    lg = (xt @ wg).astype(jnp.float32) + bg.astype(jnp.float32)
    pg = jax.nn.softmax(lg, axis=-1)
    g_sel = jnp.argmax(lg, axis=-1)
    p_group = jnp.take_along_axis(pg, g_sel[:, None], axis=-1)
    le = ((xt @ we).astype(jnp.float32) + be.astype(jnp.float32)).reshape(T, N_GROUPS, EXPERTS_PER_GROUP)
    le_sel = jnp.take_along_axis(le, g_sel[:, None, None], axis=1)[:, 0]
    top_logits, top_local = lax.top_k(le_sel, TOP_K)
    weights = p_group * jax.nn.softmax(top_logits, axis=-1)
    expert_idx = (g_sel[:, None] * EXPERTS_PER_GROUP + top_local).astype(jnp.int32)
    return expert_idx, weights


def grouped_expert_ffn(xt, expert_idx, weights, w_gate, w_up, w_down):
    T, D = xt.shape
    n_assign = T * TOP_K
    n_blocks = -(-n_assign // MOE_BLOCK) + N_EXPERTS
    n_slots = n_blocks * MOE_BLOCK
    flat_e = expert_idx.reshape(-1)
    order = jnp.argsort(flat_e)
    sorted_e = flat_e[order]
    counts = jnp.bincount(flat_e, length=N_EXPERTS)
    padded = ((counts + MOE_BLOCK - 1) // MOE_BLOCK) * MOE_BLOCK
    pad_end = jnp.cumsum(padded)
    pad_start = pad_end - padded
    start = jnp.cumsum(counts) - counts
    rank = jnp.arange(n_assign) - start[sorted_e]
    dest = pad_start[sorted_e] + rank
    token_of_slot = jnp.full((n_slots,), T, jnp.int32).at[dest].set((order // TOP_K).astype(jnp.int32))
    weight_of_slot = jnp.zeros((n_slots,), jnp.float32).at[dest].set(weights.reshape(-1)[order])
    block_expert = jnp.minimum(
        jnp.searchsorted(pad_end, jnp.arange(n_blocks) * MOE_BLOCK, side='right'), N_EXPERTS - 1)
    xpad = jnp.concatenate([xt, jnp.zeros((1, D), xt.dtype)], axis=0)

    def expert_block(args):
        tok, e = args
        xb = xpad[tok]
        hdn = jax.nn.silu(xb @ w_gate[e]) * (xb @ w_up[e])
        return hdn @ w_down[e]

    yb = lax.map(expert_block, (token_of_slot.reshape(n_blocks, MOE_BLOCK), block_expert))
    ys = yb.reshape(n_slots, D).astype(jnp.float32) * weight_of_slot[:, None]
    out = jax.ops.segment_sum(ys, token_of_slot, num_segments=T + 1)[:T]
    return out.astype(xt.dtype)


def hierarchical_moe(u, wg, bg, we, be, w_gate, w_up, w_down):
    B, S, D = u.shape
    xt = u.reshape(B * S, D)
    expert_idx, weights = hierarchical_route(xt, wg, bg, we, be)
    return grouped_expert_ffn(xt, expert_idx, weights, w_gate, w_up, w_down).reshape(B, S, D)


def setup_inputs(seed: int = 0) -> dict:
    key = jax.random.key(seed)
    ks = jax.random.split(key, 24)
    D = D_MODEL

    def nrm(k, shape, scale):
        return jax.random.normal(k, shape, jnp.float32) * scale

    x = nrm(ks[0], (BATCH, SEQ, D), 1.0)
    c = nrm(ks[1], (BATCH, D), 1.0)
    positions = (jax.random.randint(ks[2], (BATCH, 1), 0, POS_OFFSET_MAX, dtype=jnp.int32)
                 + jnp.arange(SEQ, dtype=jnp.int32)[None, :])
    return {
        "x": x,
        "c": c,
        "positions": positions,
        "ada_w": nrm(ks[3], (DEPTH, D, 6 * D), 0.5 * D ** -0.5),
        "ada_b": nrm(ks[4], (DEPTH, 6 * D), 0.02),
        "mix_norm_g": 1.0 + nrm(ks[5], (DEPTH, D), 0.02),
        "w_in": nrm(ks[6], (DEPTH, D, IN_WIDTH), D ** -0.5),
        "w_attn_branch": nrm(ks[7], (DEPTH, ATTN_WIDTH, D), ATTN_WIDTH ** -0.5),
        "w_rec_branch": nrm(ks[8], (DEPTH, REC_VWIDTH, D), REC_VWIDTH ** -0.5),
        "w_mix_out": nrm(ks[9], (DEPTH, D, D), D ** -0.5),
        "rec_norm_g": 1.0 + nrm(ks[10], (DEPTH, REC_VAL_DIM), 0.02),
        "rec_lb_logits": nrm(ks[11], (DEPTH + 1, REC_WIDTH), 0.1),
        "ffn_norm_g": 1.0 + nrm(ks[12], (DEPTH, D), 0.02),
        "router_group_w": nrm(ks[13], (DEPTH, D, N_GROUPS), D ** -0.5),
        "router_group_b": nrm(ks[14], (DEPTH, N_GROUPS), 0.01),
        "router_expert_w": nrm(ks[15], (DEPTH, D, N_EXPERTS), D ** -0.5),
        "router_expert_b": nrm(ks[16], (DEPTH, N_EXPERTS), 0.01),
        "expert_w_gate": nrm(ks[17], (DEPTH, N_EXPERTS, D, EXPERT_HIDDEN), D ** -0.5),
        "expert_w_up": nrm(ks[18], (DEPTH, N_EXPERTS, D, EXPERT_HIDDEN), D ** -0.5),
        "expert_w_down": nrm(ks[19], (DEPTH, N_EXPERTS, EXPERT_HIDDEN, D), EXPERT_HIDDEN ** -0.5),
        "final_norm_g": 1.0 + nrm(ks[20], (D,), 0.02),
    }


def reference(x, c, positions, ada_w, ada_b, mix_norm_g, w_in, w_attn_branch, w_rec_branch,
              w_mix_out, rec_norm_g, rec_lb_logits, ffn_norm_g, router_group_w, router_group_b,
              router_expert_w, router_expert_b, expert_w_gate, expert_w_up, expert_w_down,
              final_norm_g):
    cond = jax.nn.silu(c)
    lower_bounds = jnp.cumsum(jax.nn.softmax(rec_lb_logits.astype(jnp.float32), axis=0), axis=0)
    h = x
    for layer in range(DEPTH):
        mod = cond @ ada_w[layer] + ada_b[layer]
        sh_m, sc_m, gt_m, sh_f, sc_f, gt_f = jnp.split(mod, 6, axis=-1)
        u = modulate(rms_norm(h, mix_norm_g[layer]), sh_m, sc_m)
        mix = hybrid_mixer(u, positions, w_in[layer], w_attn_branch[layer], w_rec_branch[layer],
                           w_mix_out[layer], rec_norm_g[layer], lower_bounds[layer])
        h = h + gt_m[:, None, :] * mix
        u = modulate(rms_norm(h, ffn_norm_g[layer]), sh_f, sc_f)
        ffn = hierarchical_moe(u, router_group_w[layer], router_group_b[layer],
                               router_expert_w[layer], router_expert_b[layer],
                               expert_w_gate[layer], expert_w_up[layer], expert_w_down[layer])
        h = h + gt_f[:, None, :] * ffn
    return rms_norm(h, final_norm_g)
```

```cpp
#include <hip/hip_runtime.h>
#include <cstdio>
#include <cstdint>

#ifndef MK_N_LAUNCHES
#define MK_N_LAUNCHES 1
#endif

#define GAS __attribute__((address_space(1)))
#define LAS __attribute__((address_space(3)))
typedef unsigned short bf16;
typedef unsigned v4u __attribute__((ext_vector_type(4)));
typedef unsigned v2u __attribute__((ext_vector_type(2)));
typedef float f32x4 __attribute__((ext_vector_type(4)));
typedef float f32x16 __attribute__((ext_vector_type(16)));
typedef short bf16x8 __attribute__((ext_vector_type(8)));
typedef short s16x4 __attribute__((ext_vector_type(4)));
typedef GAS unsigned gu32;

constexpr int D = 2048, NB = 8, SEQ = 2048, T = NB * SEQ;
constexpr int NHEAD = 16, HD = 128;
constexpr int RB = 18432;
constexpr int NE = 32, EH = 1024;
constexpr int NPHASE = 10;
constexpr int S_QA = 0, S_KA = 2048, S_VA = 4096, S_QR = 6144, S_FR = 8192, S_IR = 10240, S_GR = 12288, S_GA = 14336, S_GB = 16384;
constexpr int S_YA = S_QA;
constexpr int S_MG = S_KA;
constexpr int S_YR = S_QR;
constexpr int S_HF = S_VA;
constexpr int S_U2 = S_FR;
constexpr int S_Y0 = S_IR, S_Y1 = S_GR;
constexpr int RBF = RB / 2;
constexpr size_t KV_VOFF = (size_t)NB * SEQ * D * 2;

constexpr size_t MiB = 1u << 20;
constexpr size_t WS_CTL = 0, CTL_ZERO_BYTES = 1 * MiB;
constexpr size_t WS_MODP = 1 * MiB;
constexpr size_t WS_MODF = 14 * MiB;
constexpr size_t WS_LB = 15 * MiB;
constexpr size_t WS_RWT = 15 * MiB + 64 * 1024;
constexpr size_t WS_TOKW = 16 * MiB;
constexpr size_t WS_LIST = 17 * MiB;
constexpr size_t WS_CNTW = 16 * MiB + 512 * 1024;
constexpr size_t WS_WIN = 20 * MiB;
constexpr size_t WS_WA = 92 * MiB, WS_WR = 100 * MiB, WS_WO = 108 * MiB;
constexpr size_t WS_W1 = 116 * MiB;
constexpr size_t WS_W2 = 372 * MiB;
constexpr size_t WS_U = 500 * MiB;
constexpr size_t WS_ROW = 608 * MiB;
constexpr size_t WS_END = 1184 * MiB;

constexpr int CW_TMO = 0, CW_CODE = 1;
constexpr int CW_QUEUE = 64;
constexpr int CW_CNT = 1024;
constexpr int CW_BAR = 4096;

constexpr int RING_BYTES = 131072;
constexpr int LDSCTL_OFF = 155648, MISC_OFF = LDSCTL_OFF + 320, TAB_OFF = LDSCTL_OFF + 1024;
constexpr int LDS_BYTES = 163840;

#define RLX_AGENT __ATOMIC_RELAXED, __HIP_MEMORY_SCOPE_AGENT
#define LDS_WAIT() asm volatile("s_waitcnt lgkmcnt(0)" ::: "memory")
#define VM_WAIT() asm volatile("s_waitcnt vmcnt(0)" ::: "memory")

__device__ __forceinline__ unsigned f2bf(float f) { unsigned u = __builtin_bit_cast(unsigned, f); return (u + 0x7fffu + ((u >> 16) & 1u)) >> 16; }
__device__ __forceinline__ unsigned pk2(float lo, float hi) { return f2bf(lo) | (f2bf(hi) << 16); }
__device__ __forceinline__ float bflo(unsigned u) { return __builtin_bit_cast(float, u << 16); }
__device__ __forceinline__ float bfhi(unsigned u) { return __builtin_bit_cast(float, u & 0xffff0000u); }
__device__ __forceinline__ unsigned cvt_pk_bf16(float lo, float hi) { unsigned r; asm volatile("v_cvt_pk_bf16_f32 %0, %1, %2" : "=v"(r) : "v"(lo), "v"(hi)); return r; }
__device__ __forceinline__ float sigmoidf_(float x) { return __builtin_amdgcn_rcpf(1.f + __expf(-x)); }
__device__ __forceinline__ float siluf_(float x) { return x * __builtin_amdgcn_rcpf(1.f + __expf(-x)); }
__device__ __forceinline__ float wave_sum(float v) {
#pragma unroll
    for (int o = 1; o < 64; o <<= 1) v += __shfl_xor(v, o);
    return v;
}

constexpr int PRE_OFF_ = 131072;
__device__ __forceinline__ int moe_entry(const LAS unsigned short* PRE, const int* list, int e, int idx) {
    const LAS unsigned short* p = PRE + e * 256; int lo = 0;
#pragma unroll
    for (int st = 128; st >= 1; st >>= 1) { if ((int)p[lo + st] <= idx) lo += st; }
    return ((const GAS int*)list)[(lo * 32 + e) * 64 + (idx - (int)p[lo])];
}
namespace pg8 {
#define PG8_LAS __attribute__((address_space(3)))
constexpr int BM = 256, BK = 64, HALF = 128, HTB = HALF * BK * 2, STAGE_BYTES = 8 * HTB, NXCD = 8, WGM = 8;
__host__ __device__ __forceinline__ int lds_byte(int r, int c) { const int st = (r >> 4) * 2 + (c >> 5), rr = r & 15, cc = c & 31, ob = rr * 64 + cc * 2; return st * 1024 + (ob ^ (((ob >> 9) & 1) << 5)); }
__host__ __device__ __forceinline__ void stage_rc(int b, int& R, int& C) { const int st = b / 1024, sb = b % 1024, swz = sb ^ (((sb >> 9) & 1) << 5); R = (st >> 1) * 16 + swz / 64; C = (st & 1) * 32 + (swz % 64) / 2; }
__host__ __device__ __forceinline__ int perm32(int rho) { const int n = rho >> 4, i = rho & 15; return 8 * (i >> 2) + 4 * n + (i & 3); }

struct Unit { int pm, pn, e, mt, rows, par; };

struct DenseOrder {
    static constexpr bool HAS_PREP = false;
    __device__ __forceinline__ void prep(const Unit&, int) const {}
    const char* A; const char* Bt; int lda, K; int nM, nN, nwg, G, c;
    __device__ void init(const void* A_, const void* Bt_, int lda_, int K_, int M, int N, int G_, int c_) { A = (const char*)A_; Bt = (const char*)Bt_; lda = lda_; K = K_; nM = M / BM; nN = N / BM; nwg = nM * nN; G = G_; c = c_; }
    __device__ __forceinline__ bool next(int i, Unit& u) const {
        const long L = (long)i * G + c; if (L >= nwg) return false;
        int wgid = (int)L; { const int q = nwg / NXCD, r = nwg % NXCD, xcd = wgid % NXCD, off = wgid / NXCD; wgid = (xcd < r ? xcd * (q + 1) : r * (q + 1) + (xcd - r) * q) + off; }
        const int nig = WGM * nN, gid = wgid / nig, fm = gid * WGM, gsz = (nM - fm) < WGM ? (nM - fm) : WGM;
        u.pm = fm + ((wgid % nig) % gsz); u.pn = (wgid % nig) / gsz; u.e = 0; u.mt = 0; u.rows = 256; return true;
    }
    __device__ __forceinline__ const char* a_tile(const Unit& u) const { return A + (size_t)u.pm * 256 * lda * 2; }
    __device__ __forceinline__ const char* b_tile(const Unit& u) const { return Bt + (size_t)u.pn * 256 * K * 2; }
    __device__ __forceinline__ void gather(const Unit&, const int (&)[2], const int (&)[2], unsigned (&)[2][2]) const {}
};

struct MoeOrder {
    static constexpr bool HAS_PREP = true;
    const LAS int* tab;
    const LAS unsigned short* pre;
    const char* A; const char* Bt; size_t b_estride; int lda, K; const int* list; int G, c; bool gath;
    __device__ __forceinline__ bool next(int i, Unit& u) const {
        const int L = i * G + c; const int NT = tab[64];
        if (L >= NT * 8) return false;
        const int tg = L >> 3; int e = 0;
        for (int k = 0; k < 32; ++k) if (tab[32 + k + 1] <= tg) e = k + 1;
        u.pm = tg; u.pn = L & 7; u.e = e; u.mt = tg - tab[32 + e]; const int rem = tab[e] - u.mt * 256; u.rows = rem < 256 ? rem : 256; return true;
    }
    __device__ __forceinline__ const char* a_tile(const Unit& u) const { return gath ? A : A + (size_t)u.pm * 256 * lda * 2; }
    __device__ __forceinline__ const char* b_tile(const Unit& u) const { return Bt + (size_t)u.e * b_estride + (size_t)u.pn * 256 * K * 2; }
    LAS int* rowtab;
    __device__ __forceinline__ void prep(const Unit& u, int slot) const {
        if (rowtab && threadIdx.x < 256) { const int r = threadIdx.x; int en = -1; if (r < u.rows) en = moe_entry(pre, list, u.e, u.mt * 256 + r); rowtab[slot * 256 + r] = en; }
    }
    __device__ __forceinline__ void gather(const Unit& u, const int (&R)[2], const int (&C)[2], unsigned (&off)[2][2]) const {
#pragma unroll
        for (int h = 0; h < 2; ++h)
#pragma unroll
            for (int i = 0; i < 2; ++i) { const int r = h * 128 + R[i]; int tok = 0; if (r < u.rows) tok = moe_entry(pre, list, u.e, u.mt * 256 + r) >> 1; off[h][i] = (unsigned)tok * (unsigned)(lda * 2) + (unsigned)(C[i] * 2); }
    }
};

template <class Epi, class Sched, bool GATHER>
__device__ __forceinline__ void gemm_phase(PG8_LAS unsigned char* lds, const int K, const int lda, const Sched& S, const Epi& E) {
    const int tid = threadIdx.x, wid = __builtin_amdgcn_readfirstlane(tid >> 6), lane = tid & 63, wr = wid >> 2, wc = wid & 3, fr = lane & 15, fq = lane >> 4;
    const int nt = K / BK;
    unsigned voffA[2], voffB[2]; int RR[2], CC[2];
#pragma unroll
    for (int i = 0; i < 2; ++i) { int R, C; stage_rc(tid * 16 + i * 8192, R, C); const int Rb = Epi::PERM ? ((R & ~31) + perm32(R & 31)) : R;
        RR[i] = R; CC[i] = C; voffA[i] = (unsigned)(R * lda + C) * 2u; voffB[i] = (unsigned)(Rb * K + C) * 2u; }
    const size_t kstep = (size_t)(BK * 2);
    const size_t hstepA = (size_t)HALF * lda * 2, hstepB = (size_t)HALF * K * 2;
    const unsigned ldsw = (unsigned)wid * 1024u;
    const int aoff = lds_byte(wr * 64 + fr, fq * 8), boff = lds_byte(wc * 32 + fr, fq * 8);
#define PG8_SA(b, h) (((b) * 2 + (h)) * HTB)
#define PG8_SB(b, h) ((4 + (b) * 2 + (h)) * HTB)
#define PG8_STAGEB(bufoff, gbase) do { _Pragma("unroll") for (int _i = 0; _i < 2; ++_i) \
        __builtin_amdgcn_global_load_lds((const unsigned*)((const char*)(gbase) + voffB[_i]), (PG8_LAS unsigned*)(lds + (bufoff) + ldsw + _i * 8192), 16, 0, 0); } while (0)
#define PG8_STAGEA(bufoff, gbase, h, GO) do { const char* _p = (const char*)(gbase) + (GATHER ? (size_t)0 : (size_t)(h) * hstepA); _Pragma("unroll") for (int _i = 0; _i < 2; ++_i) \
        __builtin_amdgcn_global_load_lds((const unsigned*)(_p + (GATHER ? GO[h][_i] : voffA[_i])), (PG8_LAS unsigned*)(lds + (bufoff) + ldsw + _i * 8192), 16, 0, 0); } while (0)
#define PG8_LDA(dst, b, h) do { _Pragma("unroll") for (int m = 0; m < 4; ++m) _Pragma("unroll") for (int k = 0; k < 2; ++k) dst[m][k] = *(const PG8_LAS bf16x8*)(lds + PG8_SA(b, h) + aoff + m * 2048 + k * 1024); } while (0)
#define PG8_LDB(dst, b, h) do { _Pragma("unroll") for (int n = 0; n < 2; ++n) _Pragma("unroll") for (int k = 0; k < 2; ++k) dst[n][k] = *(const PG8_LAS bf16x8*)(lds + PG8_SB(b, h) + boff + n * 2048 + k * 1024); } while (0)
#define PG8_MMA(ai, bj, At, Bt) do { __builtin_amdgcn_s_setprio(1); _Pragma("unroll") for (int m = 0; m < 4; ++m) _Pragma("unroll") for (int n = 0; n < 2; ++n) _Pragma("unroll") for (int k = 0; k < 2; ++k) \
        acc[ai][bj][m][n] = __builtin_amdgcn_mfma_f32_16x16x32_bf16(Bt[n][k], At[m][k], acc[ai][bj][m][n], 0, 0, 0); __builtin_amdgcn_s_setprio(0); } while (0)
#define PG8_WAIT_V(n) asm volatile("s_waitcnt vmcnt(" #n ")" ::: "memory")
#define PG8_WAIT_L(n) asm volatile("s_waitcnt lgkmcnt(" #n ")" ::: "memory")
#define PG8_BAR __builtin_amdgcn_s_barrier()
#define PG8_SCHED __builtin_amdgcn_sched_barrier(0)
    Unit cur, nxt; int ui = 0;
    if (!S.next(0, cur)) return;
    f32x4 acc[2][2][4][2];
#pragma unroll
    for (int a = 0; a < 2; ++a)
#pragma unroll
        for (int b = 0; b < 2; ++b)
#pragma unroll
            for (int m = 0; m < 4; ++m)
#pragma unroll
                for (int n = 0; n < 2; ++n) acc[a][b][m][n] = (f32x4){0.f, 0.f, 0.f, 0.f};
    bf16x8 At[4][2], B0[2][2], B1[2][2];
    unsigned gc[2][2] = {{0u, 0u}, {0u, 0u}}, gn[2][2] = {{0u, 0u}, {0u, 0u}};
    const char* cA = S.a_tile(cur); const char* cB = S.b_tile(cur);
    if (GATHER) { S.gather(cur, RR, CC, gc); }
    if (Sched::HAS_PREP) S.prep(cur, 0);
    PG8_STAGEB(PG8_SB(0, 0), cB); PG8_STAGEB(PG8_SB(0, 1), cB + hstepB); PG8_STAGEA(PG8_SA(0, 0), cA, 0, gc); PG8_STAGEA(PG8_SA(0, 1), cA, 1, gc);
    if (wr == 1) PG8_BAR;
    PG8_WAIT_V(2); PG8_BAR;
    PG8_STAGEB(PG8_SB(1, 0), cB + kstep); PG8_STAGEA(PG8_SA(1, 0), cA + kstep, 0, gc); PG8_STAGEB(PG8_SB(1, 1), cB + hstepB + kstep);
    PG8_WAIT_V(6); PG8_BAR;
    for (;;) {
        const bool has_next = S.next(ui + 1, nxt);
        const char* nA = has_next ? S.a_tile(nxt) : cA; const char* nB = has_next ? S.b_tile(nxt) : cB;
        if (Sched::HAS_PREP) { if (has_next) S.prep(nxt, (ui + 1) & 1); }
        if (GATHER) { if (has_next) S.gather(nxt, RR, CC, gn); else {
#pragma unroll
            for (int h = 0; h < 2; ++h)
#pragma unroll
                for (int i = 0; i < 2; ++i) gn[h][i] = gc[h][i]; } }
        for (int t = 0; t < nt; t += 2) {
            const bool last = (t == nt - 2);
            const char* a1 = cA + (size_t)(t + 1) * kstep;
            const char* a2 = last ? nA : cA + (size_t)(t + 2) * kstep; const char* b2 = last ? nB : cB + (size_t)(t + 2) * kstep;
            const char* a3 = a2 + kstep; const char* b3 = b2 + kstep;
            unsigned g2[2][2];
#pragma unroll
            for (int h = 0; h < 2; ++h)
#pragma unroll
                for (int i = 0; i < 2; ++i) g2[h][i] = last ? gn[h][i] : gc[h][i];
            PG8_LDB(B0, 0, 0); PG8_LDB(B1, 0, 1); PG8_SCHED; PG8_LDA(At, 0, 0); PG8_STAGEA(PG8_SA(1, 1), a1, 1, gc);
            PG8_WAIT_V(8); PG8_WAIT_L(0); PG8_BAR; PG8_MMA(0, 0, At, B0); PG8_MMA(0, 1, At, B1); PG8_BAR; PG8_SCHED;
            PG8_LDA(At, 0, 1); PG8_STAGEB(PG8_SB(0, 0), b2); PG8_STAGEB(PG8_SB(0, 1), b2 + hstepB); PG8_STAGEA(PG8_SA(0, 0), a2, 0, g2);
            PG8_WAIT_V(8); PG8_WAIT_L(0); PG8_BAR; PG8_MMA(1, 0, At, B0); PG8_MMA(1, 1, At, B1); PG8_BAR; PG8_SCHED;
            PG8_LDB(B0, 1, 0); PG8_LDB(B1, 1, 1); PG8_SCHED; PG8_LDA(At, 1, 0); PG8_STAGEA(PG8_SA(0, 1), a2, 1, g2);
            PG8_WAIT_V(8); PG8_WAIT_L(0); PG8_BAR; PG8_MMA(0, 0, At, B0); PG8_MMA(0, 1, At, B1); PG8_BAR; PG8_SCHED;
            PG8_LDA(At, 1, 1); PG8_STAGEB(PG8_SB(1, 0), b3); PG8_STAGEB(PG8_SB(1, 1), b3 + hstepB); PG8_STAGEA(PG8_SA(1, 0), a3, 0, g2);
            PG8_WAIT_V(8); PG8_WAIT_L(0); PG8_BAR; PG8_MMA(1, 0, At, B0); PG8_MMA(1, 1, At, B1); PG8_BAR; PG8_SCHED;
        }
        if (wr == 0) PG8_BAR;
        cur.par = ui & 1;
        E(acc, cur, wr, wc, fr, fq);
        if (!has_next) break;
#pragma unroll
        for (int a = 0; a < 2; ++a)
#pragma unroll
            for (int b = 0; b < 2; ++b)
#pragma unroll
                for (int m = 0; m < 4; ++m)
#pragma unroll
                    for (int n = 0; n < 2; ++n) acc[a][b][m][n] = (f32x4){0.f, 0.f, 0.f, 0.f};
        cur = nxt; cA = nA; cB = nB; ++ui;
        if (GATHER) {
#pragma unroll
            for (int h = 0; h < 2; ++h)
#pragma unroll
                for (int i = 0; i < 2; ++i) gc[h][i] = gn[h][i]; }
        if (wr == 1) PG8_BAR;
    }
    PG8_WAIT_V(0);
    PG8_BAR;
#undef PG8_SA
#undef PG8_SB
#undef PG8_STAGEA
#undef PG8_STAGEB
#undef PG8_LDA
#undef PG8_LDB
#undef PG8_MMA
#undef PG8_WAIT_V
#undef PG8_WAIT_L
#undef PG8_BAR
#undef PG8_SCHED
}
}

#define XB_TMO      128
#define XB_XCNT(j)  (256  + 64 * (j))
#define XB_XSUB(j)  (1280 + 64 * (j))
#define XB_XGEN(j)  (2304 + 64 * (j))
#define XB_TOP      3328
#define XB_TOPGEN   3392
#define XCD_BAR_WORDS 3456
#define XB_SPIN_CAP (1u << 18)
__device__ __forceinline__ unsigned xb_ld(unsigned* p)              { return __hip_atomic_load(p, __ATOMIC_RELAXED, __HIP_MEMORY_SCOPE_AGENT); }
__device__ __forceinline__ unsigned xb_add(unsigned* p, unsigned v) { return __hip_atomic_fetch_add(p, v, __ATOMIC_RELAXED, __HIP_MEMORY_SCOPE_AGENT); }
__device__ __forceinline__ unsigned xb_xcc_id() { return (unsigned)__builtin_amdgcn_s_getreg((3 << 11) | 20) & 0xFu; }
#define XB_SPIN(cond, bar) do { unsigned _sp = 0; while (cond) { __builtin_amdgcn_s_sleep(1); \
    if ((++_sp & 255u) == 0u) { if (xb_ld(&(bar)[XB_TMO])) break; if (_sp > XB_SPIN_CAP) { atomicAdd(&(bar)[XB_TMO], 1u); break; } } } } while (0)
struct XcdBarrier { unsigned* bar; unsigned x; volatile LAS unsigned* st; };
__device__ __forceinline__ XcdBarrier xcd_barrier_post(unsigned* bar, volatile LAS unsigned* st) {
    XcdBarrier b; b.bar = bar; b.x = xb_xcc_id(); b.st = st;
    if (threadIdx.x == 0) (void)xb_add(&bar[XB_XCNT(b.x)], 1u);
    return b;
}
__device__ __forceinline__ void xcd_barrier_complete(unsigned* bar, unsigned x, unsigned& nloc, unsigned& nx) {
    const unsigned G = gridDim.x * gridDim.y * gridDim.z;
    unsigned sum, cnt, mine, sp = 0u;
    for (;;) {
        sum = 0u; cnt = 0u; mine = 0u;
#pragma unroll
        for (unsigned j = 0; j < 16; ++j) { const unsigned c = xb_ld(&bar[XB_XCNT(j)]); sum += c; cnt += (c > 0u) ? 1u : 0u; mine = (j == x) ? c : mine; }
        if (sum == G) break;
        __builtin_amdgcn_s_sleep(1);
        if ((++sp & 255u) == 0u) { if (xb_ld(&bar[XB_TMO])) break; if (sp > XB_SPIN_CAP) { atomicAdd(&bar[XB_TMO], 1u); break; } }
    }
    nloc = mine > 0u ? mine : 1u; nx = cnt > 0u ? cnt : 1u;
}
__device__ __forceinline__ void xcd_barrier(const XcdBarrier& b) {
    asm volatile("s_waitcnt vmcnt(0)" ::: "memory");
    __syncthreads();
    if (threadIdx.x == 0) {
        unsigned* bar = b.bar;
        __builtin_amdgcn_s_waitcnt(0);
        unsigned nloc = b.st[0], nx = b.st[1];
        if (nloc == 0u) { xcd_barrier_complete(bar, b.x, nloc, nx); b.st[0] = nloc; b.st[1] = nx; }
        const unsigned old = xb_add(&bar[XB_XSUB(b.x)], 1u);
        const unsigned gen = old / nloc;
        if (old + 1u == (gen + 1u) * nloc) {
            __builtin_amdgcn_fence(__ATOMIC_RELEASE, "agent");
            asm volatile("s_waitcnt vmcnt(0)" ::: "memory");
            const unsigned og = xb_add(&bar[XB_TOP], 1u);
            const unsigned tg = og / nx;
            if (og + 1u == (tg + 1u) * nx) xb_add(&bar[XB_TOPGEN], 1u);
            else XB_SPIN(xb_ld(&bar[XB_TOPGEN]) == tg, bar);
            __builtin_amdgcn_fence(__ATOMIC_ACQUIRE, "agent");
            xb_add(&bar[XB_XGEN(b.x)], 1u);
            asm volatile("s_waitcnt vmcnt(0)" ::: "memory");
        } else {
            XB_SPIN(xb_ld(&bar[XB_XGEN(b.x)]) == gen, bar);
            __builtin_amdgcn_fence(__ATOMIC_ACQUIRE, "agent");
            asm volatile("s_waitcnt vmcnt(0)" ::: "memory");
        }
    }
    __syncthreads();
}

struct Frame {
    LAS unsigned char* lds;
    volatile LAS unsigned* MISC;
    gu32* ctl;
    unsigned char* ws;
    int tid, lane, wave, vcu, G;
    const float *x, *c, *ada_w, *ada_b, *mix_g, *w_in, *w_a, *w_r, *w_o, *rec_g, *lbl, *ffn_g, *rg_w, *rg_b, *re_w, *re_b, *e_gate, *e_up, *e_down, *fin_g;
    const int* pos;
    float* out;
    float *modp, *modf, *lb, *rwt, *tokw; int* list; int* cntw;
    bf16 *win_t, *wa_t, *wr_t, *wo_t, *w1_t, *w2_t, *U, *hdn, *row;
};

template <bool NT> __device__ __forceinline__ void tr_load(const float* W, int N, int lane, f32x4 (&v)[8]) {
#pragma unroll
    for (int i = 0; i < 8; ++i) { const GAS f32x4* p = (const GAS f32x4*)(W + (size_t)(8 * i + (lane >> 3)) * N + 4 * (lane & 7)); v[i] = NT ? __builtin_nontemporal_load(p) : *p; }
}
template <bool NT> __device__ __forceinline__ void tr_finish(const f32x4 (&v)[8], bf16* dst, int dK, LAS float* scr, int lane) {
#pragma unroll
    for (int i = 0; i < 8; ++i) { LAS float* q = scr + (8 * i + (lane >> 3)) * 33 + 4 * (lane & 7); q[0] = v[i].x; q[1] = v[i].y; q[2] = v[i].z; q[3] = v[i].w; }
    LDS_WAIT(); asm volatile("" ::: "memory");
    const int c = lane & 7;
#pragma unroll
    for (int j = 0; j < 4; ++j) { const int n = (lane >> 3) + 8 * j; const LAS float* s = scr + (8 * c) * 33 + n;
        v4u o; o.x = pk2(s[0 * 33], s[1 * 33]); o.y = pk2(s[2 * 33], s[3 * 33]); o.z = pk2(s[4 * 33], s[5 * 33]); o.w = pk2(s[6 * 33], s[7 * 33]);
        GAS v4u* d = (GAS v4u*)(dst + (size_t)n * dK + 8 * c); if (NT) __builtin_nontemporal_store(o, d); else *d = o; }
    LDS_WAIT(); asm volatile("" ::: "memory");
}
template <bool NT = false> __device__ __forceinline__ void tr_item(const float* W, int N, bf16* dst, int dK, LAS float* scr, int lane) {
    f32x4 v[8]; tr_load<NT>(W, N, lane, v); tr_finish<NT>(v, dst, dK, scr, lane);
}
__device__ __forceinline__ void p0_item_addr(Frame& F, int r, const float*& src, int& N, bf16*& dst, int& dK) {
    constexpr int I_IN = 32 * 576, I_SQ = 32 * 64;
    if (r < I_IN) { const int kb = r / 576, nb = r % 576; src = F.w_in + (size_t)(64 * kb) * RB + 32 * nb; N = RB; dst = F.win_t + (size_t)(32 * nb) * D + 64 * kb; dK = D; return; }
    r -= I_IN; const int w = r / I_SQ, q = r % I_SQ, kb = q / 64, nb = q % 64; const size_t so = (size_t)(64 * kb) * D + 32 * nb, dof = (size_t)(32 * nb) * D + 64 * kb;
    N = D; dK = D;
    if (w == 0) { src = F.w_a + so; dst = F.wa_t + dof; } else if (w == 1) { src = F.w_r + so; dst = F.wr_t + dof; } else { src = F.w_o + so; dst = F.wo_t + dof; }
}
__device__ __forceinline__ void p0_phase(Frame& F) {
    {
        LAS float* sc = (LAS float*)(F.lds);
        for (int it = F.vcu; it < 192; it += F.G) {
            const int kc = it / 6, nc = it % 6;
            { const int b = F.tid >> 6, k = F.tid & 63; const float cv = F.c[b * D + kc * 64 + k]; sc[b * 64 + k] = siluf_(cv); }
            __syncthreads();
            const GAS float* w = (const GAS float*)F.ada_w + (size_t)(kc * 64) * 12288 + nc * 2048 + F.tid * 4;
            f32x4 acc[8];
#pragma unroll
            for (int b = 0; b < 8; ++b) acc[b] = (f32x4){0.f, 0.f, 0.f, 0.f};
#pragma unroll 8
            for (int k = 0; k < 64; ++k) { const f32x4 wv = *(const GAS f32x4*)(w + (size_t)k * 12288);
#pragma unroll
                for (int b = 0; b < 8; ++b) acc[b] += sc[b * 64 + k] * wv; }
#pragma unroll
            for (int b = 0; b < 8; ++b) *(GAS f32x4*)(F.modp + (size_t)(kc * 8 + b) * 12288 + nc * 2048 + F.tid * 4) = acc[b];
            __syncthreads();
        }
    }
    LAS float* scr = (LAS float*)(F.lds + F.wave * 16384);
    const int gw = F.vcu * 8 + F.wave, NGW = F.G * 8;
    constexpr int I_IN = 32 * 576, I_SQ = 32 * 64, NITEMS = I_IN + 3 * I_SQ;
    for (int it = gw; it < NITEMS; it += 2 * NGW) {
        const float* s0; int N0; bf16* d0; int K0; const float* s1 = nullptr; int N1 = 0; bf16* d1 = nullptr; int K1 = 0; f32x4 va[8], vb[8];
        p0_item_addr(F, it, s0, N0, d0, K0); tr_load<false>(s0, N0, F.lane, va);
        const bool two = it + NGW < NITEMS;
        if (two) { p0_item_addr(F, it + NGW, s1, N1, d1, K1); tr_load<false>(s1, N1, F.lane, vb); }
        tr_finish<false>(va, d0, K0, scr, F.lane);
        if (two) tr_finish<false>(vb, d1, K1, scr, F.lane);
    }
}
__device__ __forceinline__ void expert_item_addr(Frame& F, int r, const float*& src, int& N, bf16*& dst, int& dK) {
    constexpr int I_EX = 32 * 1024;
    if (r < 2 * I_EX) { const int up = r >= I_EX ? 1 : 0, q = r - up * I_EX, e = q / 1024, q2 = q % 1024, kb = q2 / 32, nb = q2 % 32, n0 = 32 * nb, np = (n0 >> 7) * 256 + up * 128 + (n0 & 127);
        const size_t so = (size_t)e * D * EH + (size_t)(64 * kb) * EH + n0; src = up ? F.e_up + so : F.e_gate + so; N = EH; dst = F.w1_t + (size_t)e * D * D + (size_t)np * D + 64 * kb; dK = D; }
    else { const int q = r - 2 * I_EX, e = q / 1024, q2 = q % 1024, kb = q2 / 64, nb = q2 % 64;
        src = F.e_down + (size_t)e * EH * D + (size_t)(64 * kb) * D + 32 * nb; N = D; dst = F.w2_t + (size_t)e * D * EH + (size_t)(32 * nb) * EH + 64 * kb; dK = EH; }
}

__device__ __forceinline__ float inv_freq_rev(int i) {
    constexpr float t[16] = {0.15915494309189535f, 0.0700865215877985f, 0.03086376340470123f, 0.013591370636193905f, 0.005985185712713705f, 0.002635675898667414f, 0.001160663641240061f, 0.0005111175045375439f,
                             0.00022507907903927653f, 9.911730936901935e-05f, 4.364795279280289e-05f, 1.9221100684944863e-05f, 8.464330808241401e-06f, 3.727408601915352e-06f, 1.6414262627950345e-06f, 7.228293068832865e-07f};
    return t[i];
}
__device__ __forceinline__ void p1_phase(Frame& F) {
    const int gt = F.vcu * 512 + F.tid, GT = F.G * 512;
    for (int i = gt; i < 2048; i += GT) { const float l0 = F.lbl[i], l1 = F.lbl[2048 + i]; F.lb[i] = 1.f / (1.f + __expf(l1 - l0)); }
    for (int i = gt; i < 48 * 2048; i += GT) { const int n = i / 2048, k = i % 2048; const float wv = n < 32 ? F.re_w[k * 32 + n] : (n < 36 ? F.rg_w[k * 4 + (n - 32)] : 0.f);
        const unsigned hb = f2bf(wv); const float hv = __builtin_bit_cast(float, hb << 16); ((bf16*)F.rwt)[i] = (bf16)hb; ((bf16*)F.rwt)[48 * 2048 + i] = (bf16)f2bf(wv - hv); }
    for (int i = gt; i < 8 * 12288; i += GT) { const int b = i / 12288, n = i % 12288; float s = F.ada_b[n];
#pragma unroll 16
        for (int kc = 0; kc < 32; ++kc) s += ((const GAS float*)F.modp)[(size_t)(kc * 8 + b) * 12288 + n];
        F.modf[i] = s; }
    LAS float* sh = (LAS float*)F.lds; LAS float* sg = sh + 2048;
    for (int rb = F.vcu; rb < 256; rb += F.G) {
        const int b = rb >> 5;
        for (int k = F.tid; k < 2048; k += 512) { float s0 = F.ada_b[k], s1 = F.ada_b[2048 + k];
#pragma unroll 16
            for (int kc = 0; kc < 32; ++kc) { const GAS float* p = (const GAS float*)F.modp + (size_t)(kc * 8 + b) * 12288; s0 += p[k]; s1 += p[2048 + k]; }
            sh[k] = s0; sg[k] = (1.f + s1) * F.mix_g[k]; }
        __syncthreads();
        for (int r4 = 0; r4 < 8; r4 += 4) {
            f32x4 v[4][8]; float ss[4];
#pragma unroll
            for (int r = 0; r < 4; ++r) { const GAS f32x4* xr = (const GAS f32x4*)(F.x + (size_t)(rb * 64 + F.wave * 8 + r4 + r) * D) + F.lane;
#pragma unroll
                for (int j = 0; j < 8; ++j) v[r][j] = xr[64 * j]; }
#pragma unroll
            for (int r = 0; r < 4; ++r) { float s = 0.f;
#pragma unroll
                for (int j = 0; j < 8; ++j) s += (v[r][j].x * v[r][j].x + v[r][j].y * v[r][j].y) + (v[r][j].z * v[r][j].z + v[r][j].w * v[r][j].w);
                ss[r] = s; }
#pragma unroll
            for (int o = 1; o < 64; o <<= 1) { ss[0] += __shfl_xor(ss[0], o); ss[1] += __shfl_xor(ss[1], o); ss[2] += __shfl_xor(ss[2], o); ss[3] += __shfl_xor(ss[3], o); }
#pragma unroll
            for (int r = 0; r < 4; ++r) { const float rstd = rsqrtf(ss[r] * (1.f / D) + 1e-6f);
                GAS v2u* o8 = (GAS v2u*)(F.U + (size_t)(rb * 64 + F.wave * 8 + r4 + r) * D) + F.lane;
#pragma unroll
                for (int j = 0; j < 8; ++j) { const f32x4 g4 = *(const LAS f32x4*)(sg + 4 * (F.lane + 64 * j)), h4 = *(const LAS f32x4*)(sh + 4 * (F.lane + 64 * j));
                    const f32x4 y = v[r][j] * rstd * g4 + h4; v2u o; o.x = pk2(y.x, y.y); o.y = pk2(y.z, y.w); o8[64 * j] = o; } }
        }
        __syncthreads();
    }
}

__device__ __forceinline__ constexpr float cut11(float c) { return __builtin_bit_cast(float, __builtin_bit_cast(unsigned, c) & 0xffffe000u); }
struct EpiProj {
    static constexpr bool PERM = true;
    bf16* O; const int* pos; bf16* KV;
    __device__ __forceinline__ void operator()(const f32x4 (&acc)[2][2][4][2], const pg8::Unit& u, int wr, int wc, int fr, int fq) const {
        const int sec = u.pn >> 3;
        const int row0 = u.pm * 256 + wr * 64 + fr, col0 = u.pn * 256 + wc * 32 + 8 * fq;
        const bool rot = (sec < 2) && (wc == 0);
        const float qs = (sec == 0) ? 0.12751743082459868f : 1.f;
        float pf[2][4];
#pragma unroll
        for (int ai = 0; ai < 2; ++ai)
#pragma unroll
            for (int m = 0; m < 4; ++m) pf[ai][m] = rot ? (float)((const GAS int*)pos)[row0 + ai * 128 + m * 16] : 0.f;
#pragma unroll
        for (int ai = 0; ai < 2; ++ai)
#pragma unroll
            for (int m = 0; m < 4; ++m) {
                const int row = row0 + ai * 128 + m * 16;
#pragma unroll
                for (int bj = 0; bj < 2; ++bj) {
                    float v[8];
#pragma unroll
                    for (int j = 0; j < 4; ++j) { v[j] = acc[ai][bj][m][0][j]; v[4 + j] = acc[ai][bj][m][1][j]; }
                    if (rot) {
#pragma unroll
                        for (int j = 0; j < 8; ++j) {
                            const float ch = (fq & 1) ? cut11(inv_freq_rev(8 + j)) : cut11(inv_freq_rev(j)), cl = (fq & 1) ? (inv_freq_rev(8 + j) - cut11(inv_freq_rev(8 + j))) : (inv_freq_rev(j) - cut11(inv_freq_rev(j)));
                            const float p0 = pf[ai][m] * ch; const float fr_ = (p0 - __builtin_floorf(p0)) + pf[ai][m] * cl;
                            const float sn = __builtin_amdgcn_sinf(fr_), cs = __builtin_amdgcn_cosf(fr_);
                            const float other = __shfl_xor(v[j], 32);
                            v[j] = v[j] * cs + ((fq < 2) ? -other : other) * sn;
                        }
                    }
                    if (sec == 0) {
#pragma unroll
                        for (int j = 0; j < 8; ++j) v[j] *= qs;
                    } else if (sec == 3 || sec == 6) {
#pragma unroll
                        for (int j = 0; j < 8; ++j) v[j] = siluf_(v[j]);
                    } else if (sec >= 7) {
#pragma unroll
                        for (int j = 0; j < 8; ++j) v[j] = sigmoidf_(v[j]);
                    }
                    v4u w; w.x = cvt_pk_bf16(v[0], v[1]); w.y = cvt_pk_bf16(v[2], v[3]); w.z = cvt_pk_bf16(v[4], v[5]); w.w = cvt_pk_bf16(v[6], v[7]);
                    if (sec == 1 || sec == 2) {
                        const int hd = (u.pn & 7) * 2 + bj;
                        *(GAS v4u*)(KV + (size_t)(sec - 1) * (KV_VOFF / 2) + ((size_t)((row >> 11) * NHEAD + hd) * SEQ + (row & (SEQ - 1))) * HD + wc * 32 + 8 * fq) = w;
                    } else *(GAS v4u*)(O + (size_t)row * RB + col0 + bj * 128) = w;
                }
            }
    }
};
template <int SECOND> struct EpiGate {
    static constexpr bool PERM = true;
    bf16* R;
    __device__ __forceinline__ void operator()(const f32x4 (&acc)[2][2][4][2], const pg8::Unit& u, int wr, int wc, int fr, int fq) const {
        const int row0 = u.pm * 256 + wr * 64 + fr, col0 = u.pn * 256 + wc * 32 + 8 * fq;
#pragma unroll
        for (int ai = 0; ai < 2; ++ai) {
            v4u g[4][2], t[4][2];
#pragma unroll
            for (int m = 0; m < 4; ++m)
#pragma unroll
                for (int bj = 0; bj < 2; ++bj) { const bf16* rp = R + (size_t)(row0 + ai * 128 + m * 16) * RB + col0 + bj * 128; g[m][bj] = *(const GAS v4u*)(rp + (SECOND ? S_GB : S_GA)); if (SECOND) t[m][bj] = *(const GAS v4u*)(rp + S_MG); }
#pragma unroll
            for (int m = 0; m < 4; ++m)
#pragma unroll
                for (int bj = 0; bj < 2; ++bj) {
                    bf16* rp = R + (size_t)(row0 + ai * 128 + m * 16) * RB + col0 + bj * 128;
                    float v[8]; const v4u gg = g[m][bj];
#pragma unroll
                    for (int j = 0; j < 4; ++j) { v[j] = acc[ai][bj][m][0][j]; v[4 + j] = acc[ai][bj][m][1][j]; }
                    v[0] *= bflo(gg.x); v[1] *= bfhi(gg.x); v[2] *= bflo(gg.y); v[3] *= bfhi(gg.y); v[4] *= bflo(gg.z); v[5] *= bfhi(gg.z); v[6] *= bflo(gg.w); v[7] *= bfhi(gg.w);
                    if (SECOND) { const v4u tt = t[m][bj];
                        v[0] += bflo(tt.x); v[1] += bfhi(tt.x); v[2] += bflo(tt.y); v[3] += bfhi(tt.y); v[4] += bflo(tt.z); v[5] += bfhi(tt.z); v[6] += bflo(tt.w); v[7] += bfhi(tt.w); }
                    v4u w; w.x = cvt_pk_bf16(v[0], v[1]); w.y = cvt_pk_bf16(v[2], v[3]); w.z = cvt_pk_bf16(v[4], v[5]); w.w = cvt_pk_bf16(v[6], v[7]);
                    *(GAS v4u*)(rp + S_MG) = w;
                }
        }
    }
};
struct EpiH {
    static constexpr bool PERM = true;
    const float* modf; bf16* R;
    __device__ __forceinline__ void operator()(const f32x4 (&acc)[2][2][4][2], const pg8::Unit& u, int wr, int wc, int fr, int fq) const {
        const int row0 = u.pm * 256 + wr * 64 + fr, col0 = u.pn * 256 + wc * 32 + 8 * fq;
        const GAS float* gt = (const GAS float*)modf + (size_t)(u.pm >> 3) * 12288 + 2 * D;
        f32x4 gv[2][2];
#pragma unroll
        for (int bj = 0; bj < 2; ++bj)
#pragma unroll
            for (int n = 0; n < 2; ++n) gv[bj][n] = *(const GAS f32x4*)(gt + col0 + bj * 128 + 4 * n);
#pragma unroll
        for (int ai = 0; ai < 2; ++ai)
#pragma unroll
            for (int m = 0; m < 4; ++m)
#pragma unroll
                for (int bj = 0; bj < 2; ++bj) { const f32x4 d0 = gv[bj][0] * acc[ai][bj][m][0], d1 = gv[bj][1] * acc[ai][bj][m][1];
                    v4u w; w.x = cvt_pk_bf16(d0[0], d0[1]); w.y = cvt_pk_bf16(d0[2], d0[3]); w.z = cvt_pk_bf16(d1[0], d1[1]); w.w = cvt_pk_bf16(d1[2], d1[3]);
                    *(GAS v4u*)(R + (size_t)(row0 + ai * 128 + m * 16) * RB + S_HF + col0 + bj * 128) = w; }
    }
};
struct EpiSwiGLU {
    static constexpr bool PERM = true;
    bf16* H;
    __device__ __forceinline__ void operator()(const f32x4 (&acc)[2][2][4][2], const pg8::Unit& u, int wr, int wc, int fr, int fq) const {
        const int row0 = u.pm * 256 + wr * 64 + fr, col0 = u.pn * 128 + wc * 32 + 8 * fq;
#pragma unroll
        for (int ai = 0; ai < 2; ++ai)
#pragma unroll
            for (int m = 0; m < 4; ++m) { float v[8];
#pragma unroll
                for (int j = 0; j < 4; ++j) { v[j] = siluf_(acc[ai][0][m][0][j]) * acc[ai][1][m][0][j]; v[4 + j] = siluf_(acc[ai][0][m][1][j]) * acc[ai][1][m][1][j]; }
                v4u w; w.x = cvt_pk_bf16(v[0], v[1]); w.y = cvt_pk_bf16(v[2], v[3]); w.z = cvt_pk_bf16(v[4], v[5]); w.w = cvt_pk_bf16(v[6], v[7]);
                *(GAS v4u*)(H + (size_t)(row0 + ai * 128 + m * 16) * EH + col0) = w; }
    }
};
struct EpiScatter {
    static constexpr bool PERM = true;
    bf16* R; const int* list; const LAS unsigned short* pre; const LAS int* rowtab;
    __device__ __forceinline__ void operator()(const f32x4 (&acc)[2][2][4][2], const pg8::Unit& u, int wr, int wc, int fr, int fq) const {
        const int col0 = u.pn * 256 + wc * 32 + 8 * fq;
        int en[2][4];
#pragma unroll
        for (int ai = 0; ai < 2; ++ai)
#pragma unroll
            for (int m = 0; m < 4; ++m) { const int r = ai * 128 + wr * 64 + m * 16 + fr; en[ai][m] = rowtab[u.par * 256 + r]; }
#pragma unroll
        for (int ai = 0; ai < 2; ++ai)
#pragma unroll
            for (int m = 0; m < 4; ++m) {
                if (en[ai][m] >= 0) { bf16* rp = R + (size_t)(en[ai][m] >> 1) * RB + ((en[ai][m] & 1) ? S_Y1 : S_Y0) + col0;
#pragma unroll
                    for (int bj = 0; bj < 2; ++bj) { v4u w; w.x = cvt_pk_bf16(acc[ai][bj][m][0][0], acc[ai][bj][m][0][1]); w.y = cvt_pk_bf16(acc[ai][bj][m][0][2], acc[ai][bj][m][0][3]);
                        w.z = cvt_pk_bf16(acc[ai][bj][m][1][0], acc[ai][bj][m][1][1]); w.w = cvt_pk_bf16(acc[ai][bj][m][1][2], acc[ai][bj][m][1][3]); *(GAS v4u*)(rp + bj * 128) = w; } } }
    }
};

__device__ __forceinline__ unsigned short f2bf16(float f) { return (unsigned short)f2bf(f); }
__device__ __forceinline__ void hgrn_unit2(Frame& F, int b, int h) {
    LAS unsigned char* L = F.lds;
    constexpr int PQ = 272, PL = 288, PP = 144, POF = 132;
    constexpr int QE_OFF = 0, KE_OFF = 64 * PQ, KL_OFF = 2 * 64 * PQ, V_OFF = KL_OFF + 64 * PL, P_OFF = V_OFF + 64 * PL, O_OFF = P_OFF + 64 * PP, DEC_OFF = O_OFF + 64 * POF * 4, QS_OFF = DEC_OFF + 512;
    constexpr int RF_OFF = QS_OFF + 2048, RQ_OFF = RF_OFF + 16384;
    static_assert(RQ_OFF + 16384 <= LDSCTL_OFF, "hgrn LDS map");
    const int tid = F.tid, lane = F.lane, w = F.wave, l15 = lane & 15, g = lane >> 4, q4 = l15 >> 2, p4 = l15 & 3;
    const int kcol = tid & 127, tq = tid >> 7;
    const float lbk = F.lb[h * 128 + kcol];
    f32x4 st[8];
#pragma unroll
    for (int kt = 0; kt < 8; ++kt) st[kt] = (f32x4){0.f, 0.f, 0.f, 0.f};
    LAS float* QS = (LAS float*)(L + QS_OFF); LAS float* DEC = (LAS float*)(L + DEC_OFF); LAS float* O = (LAS float*)(L + O_OFF);
    v4u pfF[2], pfQ[2], pfV[2], pfG[2];
    const bf16* ubase = F.row + (size_t)b * SEQ * RB + h * 128;
    const unsigned po0c = (unsigned)(tid >> 4) * (unsigned)(RB * 2) + (unsigned)((tid & 15) * 16), po1c = po0c + 32u * (unsigned)(RB * 2);
    const unsigned pogc = (unsigned)(tid >> 3) * (unsigned)(RB * 2) + (unsigned)((16 * (tid & 7) + S_GR) * 2);
#define HG_PF_BASE(ch_) const GAS char* cb_ = (const GAS char*)ubase + (size_t)((ch_) * 64) * (RB * 2); unsigned po0 = po0c, po1 = po1c, pog = pogc; asm volatile("" : "+v"(po0), "+v"(po1), "+v"(pog));
#define HG_PF_F(ch_) do { HG_PF_BASE(ch_) pfF[0] = *(const GAS v4u*)(cb_ + po0 + S_FR * 2); pfF[1] = *(const GAS v4u*)(cb_ + po1 + S_FR * 2); (void)pog; } while (0)
#define HG_PF_Q(ch_) do { HG_PF_BASE(ch_) pfQ[0] = *(const GAS v4u*)(cb_ + po0 + S_QR * 2); pfQ[1] = *(const GAS v4u*)(cb_ + po1 + S_QR * 2); (void)pog; } while (0)
#define HG_PF_V(ch_) do { HG_PF_BASE(ch_) pfV[0] = *(const GAS v4u*)(cb_ + po0 + S_IR * 2); pfV[1] = *(const GAS v4u*)(cb_ + po1 + S_IR * 2); (void)pog; } while (0)
#define HG_PF_G(ch_) do { HG_PF_BASE(ch_) pfG[0] = *(const GAS v4u*)(cb_ + pog); pfG[1] = *(const GAS v4u*)(cb_ + pog + 16); (void)po0; (void)po1; } while (0)
#define HG_PREFETCH(ch_) do { HG_PF_F(ch_); HG_PF_Q(ch_); HG_PF_V(ch_); HG_PF_G(ch_); } while (0)
#define HG_BAR() do { asm volatile("s_waitcnt lgkmcnt(0)" ::: "memory"); __builtin_amdgcn_s_barrier(); asm volatile("" ::: "memory"); } while (0)
    v4u pend0 = {0u, 0u, 0u, 0u}, pend1 = pend0; bf16* pendp = nullptr;
    HG_PREFETCH(0);
    for (int ch = 0; ch < 32; ++ch) {
        const size_t row0 = (size_t)b * SEQ + ch * 64;
#pragma unroll
        for (int r = 0; r < 2; ++r) { const int idx = tid + 512 * r, s = idx >> 4, chn = idx & 15;
            *(LAS v4u*)(L + RF_OFF + s * 256 + chn * 16) = pfF[r]; *(LAS v4u*)(L + RQ_OFF + s * 256 + chn * 16) = pfQ[r]; *(LAS v4u*)(L + V_OFF + s * PL + chn * 16) = pfV[r]; }
        const v4u g0 = pfG[0], g1 = pfG[1];
        if (ch > 0) { *(GAS v4u*)(pendp + S_YR) = pend0; *(GAS v4u*)(pendp + S_YR + 8) = pend1; }
        HG_BAR();
        if (ch < 31) HG_PF_F(ch + 1);
        float cb[16], kk[16], qv[16]; float run = 0.f;
#pragma unroll
        for (int i = 0; i < 16; ++i) { const float xf = __builtin_bit_cast(float, (unsigned)*(const LAS unsigned short*)(L + RF_OFF + (16 * tq + i) * 256 + kcol * 2) << 16);
            qv[i] = __builtin_bit_cast(float, (unsigned)*(const LAS unsigned short*)(L + RQ_OFF + (16 * tq + i) * 256 + kcol * 2) << 16);
            const float f = lbk + (1.f - lbk) * sigmoidf_(xf); run += __logf(f); cb[i] = run; kk[i] = 1.f - f; }
        QS[tq * 128 + kcol] = run;
        HG_BAR();
        if (ch < 31) HG_PF_Q(ch + 1);
        { float off = 0.f, tot = 0.f;
#pragma unroll
          for (int q = 0; q < 4; ++q) { const float z = QS[q * 128 + kcol]; off += (q < tq) ? z : 0.f; tot += z; }
#pragma unroll
          for (int i = 0; i < 16; ++i) { const float bb = off + cb[i], eb = __expf(bb);
              *(LAS unsigned short*)(L + QE_OFF + (16 * tq + i) * PQ + kcol * 2) = f2bf16(qv[i] * eb);
              *(LAS unsigned short*)(L + KE_OFF + (16 * tq + i) * PQ + kcol * 2) = f2bf16(kk[i] * __expf(-bb));
              *(LAS unsigned short*)(L + KL_OFF + (16 * tq + i) * PL + kcol * 2) = f2bf16(kk[i] * __expf(tot - bb)); }
          if (tq == 0) DEC[kcol] = __expf(tot); }
        HG_BAR();
        if (ch < 31) HG_PF_V(ch + 1);
        { const int tt = w >> 1;
#pragma unroll
          for (int si = 0; si < 2; ++si) { const int ss = 2 * (w & 1) + si; f32x4 acc = {0.f, 0.f, 0.f, 0.f};
              if (ss <= tt) {
#pragma unroll
                  for (int ks = 0; ks < 4; ++ks) { const bf16x8 a = *(const LAS bf16x8*)(L + QE_OFF + (16 * tt + l15) * PQ + ks * 64 + g * 16), bq = *(const LAS bf16x8*)(L + KE_OFF + (16 * ss + l15) * PQ + ks * 64 + g * 16);
                      acc = __builtin_amdgcn_mfma_f32_16x16x32_bf16(a, bq, acc, 0, 0, 0); } }
#pragma unroll
              for (int r = 0; r < 4; ++r) { const float val = (16 * ss + l15 <= 16 * tt + 4 * g + r) ? acc[r] : 0.f; *(LAS unsigned short*)(L + P_OFF + (16 * tt + 4 * g + r) * PP + (16 * ss + l15) * 2) = f2bf16(val); } } }
        HG_BAR();
        if (ch < 31) HG_PF_G(ch + 1);
        { bf16x8 vb[2];
#pragma unroll
          for (int ks = 0; ks < 2; ++ks) { const s16x4 lo = __builtin_amdgcn_ds_read_tr16_b64_v4i16((LAS s16x4*)(L + V_OFF + (32 * ks + 8 * g + q4) * PL + (16 * w + 4 * p4) * 2));
              const s16x4 hi = __builtin_amdgcn_ds_read_tr16_b64_v4i16((LAS s16x4*)(L + V_OFF + (32 * ks + 8 * g + 4 + q4) * PL + (16 * w + 4 * p4) * 2)); vb[ks] = __builtin_shufflevector(lo, hi, 0, 1, 2, 3, 4, 5, 6, 7); }
          f32x4 oacc[4];
#pragma unroll
          for (int tt = 0; tt < 4; ++tt) { oacc[tt] = (f32x4){0.f, 0.f, 0.f, 0.f};
#pragma unroll
              for (int ks = 0; ks < 2; ++ks) if (32 * ks <= 16 * tt + 15) { const bf16x8 a = *(const LAS bf16x8*)(L + P_OFF + (16 * tt + l15) * PP + ks * 64 + g * 16); oacc[tt] = __builtin_amdgcn_mfma_f32_16x16x32_bf16(a, vb[ks], oacc[tt], 0, 0, 0); } }
#pragma unroll
          for (int ks = 0; ks < 4; ++ks) { v4u pk; pk.x = cvt_pk_bf16(st[2 * ks][0], st[2 * ks][1]); pk.y = cvt_pk_bf16(st[2 * ks][2], st[2 * ks][3]); pk.z = cvt_pk_bf16(st[2 * ks + 1][0], st[2 * ks + 1][1]); pk.w = cvt_pk_bf16(st[2 * ks + 1][2], st[2 * ks + 1][3]);
              const bf16x8 sb = __builtin_bit_cast(bf16x8, pk);
#pragma unroll
              for (int tt = 0; tt < 4; ++tt) { const s16x4 alo = *(const LAS s16x4*)(L + QE_OFF + (16 * tt + l15) * PQ + (32 * ks + 4 * g) * 2), ahi = *(const LAS s16x4*)(L + QE_OFF + (16 * tt + l15) * PQ + (32 * ks + 16 + 4 * g) * 2);
                  const bf16x8 a = __builtin_shufflevector(alo, ahi, 0, 1, 2, 3, 4, 5, 6, 7); oacc[tt] = __builtin_amdgcn_mfma_f32_16x16x32_bf16(a, sb, oacc[tt], 0, 0, 0); } }
#pragma unroll
          for (int tt = 0; tt < 4; ++tt)
#pragma unroll
              for (int r = 0; r < 4; ++r) O[(16 * tt + 4 * g + r) * POF + 16 * w + l15] = oacc[tt][r];
#pragma unroll
          for (int kt = 0; kt < 8; ++kt) { const f32x4 d4 = *(const LAS f32x4*)(DEC + 16 * kt + 4 * g); st[kt] = st[kt] * d4;
#pragma unroll
              for (int ks = 0; ks < 2; ++ks) { const s16x4 lo = __builtin_amdgcn_ds_read_tr16_b64_v4i16((LAS s16x4*)(L + KL_OFF + (32 * ks + 8 * g + q4) * PL + (16 * kt + 4 * p4) * 2));
                  const s16x4 hi = __builtin_amdgcn_ds_read_tr16_b64_v4i16((LAS s16x4*)(L + KL_OFF + (32 * ks + 8 * g + 4 + q4) * PL + (16 * kt + 4 * p4) * 2));
                  const bf16x8 a = __builtin_shufflevector(lo, hi, 0, 1, 2, 3, 4, 5, 6, 7); st[kt] = __builtin_amdgcn_mfma_f32_16x16x32_bf16(a, vb[ks], st[kt], 0, 0, 0); } } }
        HG_BAR();

        { const int t = tid >> 3, vq = tid & 7; f32x4 o4[4]; float ss = 0.f;
#pragma unroll
          for (int j = 0; j < 4; ++j) { o4[j] = *(const LAS f32x4*)(O + t * POF + 16 * vq + 4 * j); ss += (o4[j].x * o4[j].x + o4[j].y * o4[j].y) + (o4[j].z * o4[j].z + o4[j].w * o4[j].w); }
          ss += __shfl_xor(ss, 1); ss += __shfl_xor(ss, 2); ss += __shfl_xor(ss, 4);
          const float rstd = rsqrtf(ss * (1.f / 128.f) + 1e-6f);
          bf16* rp = F.row + (row0 + t) * RB + h * 128 + 16 * vq;
          const GAS f32x4* ngp = (const GAS f32x4*)(F.rec_g + 16 * vq);
          const f32x4 n0 = ngp[0], n1 = ngp[1], n2 = ngp[2], n3 = ngp[3];
          v4u w0, w1;
          w0.x = pk2(o4[0].x * rstd * n0.x * bflo(g0.x), o4[0].y * rstd * n0.y * bfhi(g0.x)); w0.y = pk2(o4[0].z * rstd * n0.z * bflo(g0.y), o4[0].w * rstd * n0.w * bfhi(g0.y));
          w0.z = pk2(o4[1].x * rstd * n1.x * bflo(g0.z), o4[1].y * rstd * n1.y * bfhi(g0.z)); w0.w = pk2(o4[1].z * rstd * n1.z * bflo(g0.w), o4[1].w * rstd * n1.w * bfhi(g0.w));
          w1.x = pk2(o4[2].x * rstd * n2.x * bflo(g1.x), o4[2].y * rstd * n2.y * bfhi(g1.x)); w1.y = pk2(o4[2].z * rstd * n2.z * bflo(g1.y), o4[2].w * rstd * n2.w * bfhi(g1.y));
          w1.z = pk2(o4[3].x * rstd * n3.x * bflo(g1.z), o4[3].y * rstd * n3.y * bfhi(g1.z)); w1.w = pk2(o4[3].z * rstd * n3.z * bflo(g1.w), o4[3].w * rstd * n3.w * bfhi(g1.w));
          pend0 = w0; pend1 = w1; pendp = rp; }
    }
    *(GAS v4u*)(pendp + S_YR) = pend0; *(GAS v4u*)(pendp + S_YR + 8) = pend1;
#undef HG_PREFETCH
#undef HG_PF_BASE
#undef HG_PF_F
#undef HG_PF_Q
#undef HG_PF_V
#undef HG_PF_G
#undef HG_BAR
    __syncthreads();
}

__device__ __forceinline__ int crow(int r, int hi) { return (r & 3) + 8 * (r >> 2) + 4 * hi; }
__device__ __forceinline__ void glds16(const void* gsrc, unsigned lds_dst) { unsigned keep;
    asm volatile("s_mov_b32 %0, m0\n\ts_mov_b32 m0, %2\n\ts_nop 0\n\tglobal_load_lds_dwordx4 %1, off\n\ts_mov_b32 m0, %0" : "=&s"(keep) : "v"(gsrc), "s"(lds_dst) : "memory"); }
__device__ __forceinline__ int swzf(int row) { return ((row & 3) << 2) | ((row >> 2) & 3); }
__device__ __forceinline__ void vm_wait_n(int n) {
    if (n >= 60) asm volatile("s_waitcnt vmcnt(60)" ::: "memory"); else if (n >= 52) asm volatile("s_waitcnt vmcnt(52)" ::: "memory"); else if (n >= 28) asm volatile("s_waitcnt vmcnt(28)" ::: "memory");
    else if (n >= 24) asm volatile("s_waitcnt vmcnt(24)" ::: "memory"); else if (n >= 20) asm volatile("s_waitcnt vmcnt(20)" ::: "memory"); else if (n >= 16) asm volatile("s_waitcnt vmcnt(16)" ::: "memory");
    else if (n >= 4) asm volatile("s_waitcnt vmcnt(4)" ::: "memory"); else if (n >= 2) asm volatile("s_waitcnt vmcnt(2)" ::: "memory"); else asm volatile("s_waitcnt vmcnt(0)" ::: "memory");
}
template <int PIDX> __device__ __forceinline__ void attn_slide(Frame& F, bf16* base, const bf16* kvb, float* lsc, bf16* o2) {
    constexpr int R = (PIDX == 0) ? 1 : (PIDX == 1 ? 4 : 16), CL = (PIDX == 0) ? 64 : (PIDX == 1 ? 16 : 4), NT = 64, NS = 4;
    const int lane = F.lane, w = F.wave, qi = lane & 31, hh = lane >> 5;
    LAS unsigned char* ring = F.lds; const unsigned ringb = (unsigned)(size_t)ring;
    LAS unsigned char* qim = F.lds + 65536 + w * 8192; const unsigned qimb = (unsigned)(size_t)qim;
    const int G16 = lane >> 4, q4 = (lane & 15) >> 2, p4 = lane & 3;
    const int kg0 = hh ^ swzf(qi);
    int srow = 4 * w + (lane >> 4), sch = (lane & 15) ^ swzf(srow); asm volatile("" : "+v"(srow), "+v"(sch));
#define SL_STAGE(T_) do { const int tt_ = (T_); int sr_ = srow, sc_ = sch; asm volatile("" : "+v"(sr_), "+v"(sc_)); const unsigned off_ = (unsigned)((32 * (tt_ % CL) + sr_) * R + (tt_ / CL)) * 256u + (unsigned)(sc_ * 16); \
        const unsigned ld_ = (unsigned)__builtin_amdgcn_readfirstlane((int)(ringb + (unsigned)((tt_ & (NS - 1)) * 16384 + w * 1024))); \
        glds16((const void*)((const char*)kvb + off_), ld_); glds16((const void*)((const char*)kvb + KV_VOFF + off_), ld_ + 8192u); } while (0)
#define SL_QLOAD(QT_) do { const int qq_ = (QT_); int l4_ = lane >> 4, l15_ = lane & 15; asm volatile("" : "+v"(l4_), "+v"(l15_)); _Pragma("unroll") for (int pc_ = 0; pc_ < 8; ++pc_) { const int rw_ = 4 * pc_ + l4_; const int ch_ = l15_ ^ swzf(rw_); \
        const unsigned off_ = (unsigned)((32 * (qq_ % CL) + rw_) * R + (qq_ / CL)) * (unsigned)(RB * 2) + (unsigned)((S_QA + ch_ * 8) * 2); \
        glds16((const void*)((const char*)base + off_), (unsigned)__builtin_amdgcn_readfirstlane((int)(qimb + (unsigned)(pc_ * 1024)))); } } while (0)
    SL_STAGE(0); SL_STAGE(1); SL_STAGE(2);
    int QT = w; SL_QLOAD(QT);
    asm volatile("s_waitcnt vmcnt(0)" ::: "memory");
    f32x16 o[4];
#pragma unroll
    for (int dt = 0; dt < 4; ++dt)
#pragma unroll
        for (int e = 0; e < 16; ++e) o[dt][e] = 0.f;
    float mrun = -1e30f, l = 0.f;
    int k = 100;
#define SL_FINAL() do { l += __shfl_xor(l, 32); const float inv_ = 1.f / l, lse_ = mrun + __builtin_amdgcn_logf(l); const int tq_ = (32 * (QT % CL) + qi) * R + (QT / CL); \
        const unsigned yo_ = (PIDX == 2) ? ((unsigned)tq_ * 256u + (unsigned)(8 * hh)) : ((unsigned)tq_ * (unsigned)(RB * 2) + (unsigned)(((PIDX == 0 ? S_KA : S_VA) + 4 * hh) * 2)); \
        GAS char* ob_ = (PIDX == 2) ? (GAS char*)o2 : (GAS char*)base; \
        _Pragma("unroll") for (int dt = 0; dt < 4; ++dt) _Pragma("unroll") for (int g = 0; g < 4; ++g) { v2u pk; pk.x = cvt_pk_bf16(o[dt][4 * g] * inv_, o[dt][4 * g + 1] * inv_); pk.y = cvt_pk_bf16(o[dt][4 * g + 2] * inv_, o[dt][4 * g + 3] * inv_); \
            *(GAS v2u*)(ob_ + yo_ + (unsigned)(64 * dt + 16 * g)) = pk; } \
        if (hh == 0) lsc[tq_] = lse_; \
        _Pragma("unroll") for (int dt = 0; dt < 4; ++dt) _Pragma("unroll") for (int e = 0; e < 16; ++e) o[dt][e] = 0.f; mrun = -1e30f; l = 0.f; } while (0)
    float pa1 = 0.f; unsigned pyo = 0u;
#define SL_M1() do { l += __shfl_xor(l, 32); const int tq_ = (32 * (QT % CL) + qi) * R + (QT / CL); pyo = (unsigned)tq_ * (unsigned)(RB * 2) + (unsigned)(8 * hh); \
        const float pl0_ = ((const GAS float*)lsc)[tq_ - 4096], pl1_ = ((const GAS float*)lsc)[tq_ - 2048]; v2u px_[16]; \
        _Pragma("unroll") for (int i_ = 0; i_ < 16; ++i_) px_[i_] = *(const GAS v2u*)((const GAS char*)base + S_KA * 2 + pyo + (unsigned)(64 * (i_ >> 2) + 16 * (i_ & 3))); \
        const float plse_ = mrun + __builtin_amdgcn_logf(l), M_ = fmaxf(fmaxf(pl0_, pl1_), plse_), w0_ = __builtin_amdgcn_exp2f(pl0_ - M_), w1_ = __builtin_amdgcn_exp2f(pl1_ - M_), w2_ = __builtin_amdgcn_exp2f(plse_ - M_), dn_ = 1.f / (w0_ + w1_ + w2_); \
        const float a0_ = w0_ * dn_, a2_ = w2_ * dn_ / l; pa1 = w1_ * dn_; \
        _Pragma("unroll") for (int i_ = 0; i_ < 16; ++i_) { const v2u x_ = px_[i_]; const int dt_ = i_ >> 2, g_ = i_ & 3; \
            o[dt_][4 * g_] = a2_ * o[dt_][4 * g_] + a0_ * bflo(x_.x); o[dt_][4 * g_ + 1] = a2_ * o[dt_][4 * g_ + 1] + a0_ * bfhi(x_.x); o[dt_][4 * g_ + 2] = a2_ * o[dt_][4 * g_ + 2] + a0_ * bflo(x_.y); o[dt_][4 * g_ + 3] = a2_ * o[dt_][4 * g_ + 3] + a0_ * bfhi(x_.y); } } while (0)
#define SL_M2() do { v2u px_[16]; \
        _Pragma("unroll") for (int i_ = 0; i_ < 16; ++i_) px_[i_] = *(const GAS v2u*)((const GAS char*)base + S_VA * 2 + pyo + (unsigned)(64 * (i_ >> 2) + 16 * (i_ & 3))); \
        _Pragma("unroll") for (int i_ = 0; i_ < 16; ++i_) { const v2u x_ = px_[i_]; const int dt_ = i_ >> 2, g_ = i_ & 3; v2u pk; \
            pk.x = cvt_pk_bf16(o[dt_][4 * g_] + pa1 * bflo(x_.x), o[dt_][4 * g_ + 1] + pa1 * bfhi(x_.x)); pk.y = cvt_pk_bf16(o[dt_][4 * g_ + 2] + pa1 * bflo(x_.y), o[dt_][4 * g_ + 3] + pa1 * bfhi(x_.y)); \
            *(GAS v2u*)((GAS char*)base + S_YA * 2 + pyo + (unsigned)(64 * dt_ + 16 * g_)) = pk; } \
        _Pragma("unroll") for (int dt = 0; dt < 4; ++dt) _Pragma("unroll") for (int e = 0; e < 16; ++e) o[dt][e] = 0.f; mrun = -1e30f; l = 0.f; } while (0)
    for (int T = 0; T < NT; ++T) {
        { const int dm = (NT - 1 - T) < 2 ? 2 * (NT - 1 - T) : 4;
          const int e1 = 16, e2 = ((PIDX == 2) ? 32 : 0) + (QT < NT ? 8 : 0);
          const int allowed = (k == 4) ? (dm < 2 ? dm : 2) : (dm + (k == 2 ? e1 : (k == 3 ? e1 + e2 : 0)));
          vm_wait_n(allowed); }
        asm volatile("s_waitcnt lgkmcnt(0)" ::: "memory"); __builtin_amdgcn_s_barrier(); asm volatile("" ::: "memory");
        if (T + NS - 1 < NT) SL_STAGE(T + NS - 1);
        const int lo = (QT - 4) > CL * (QT / CL) ? (QT - 4) : CL * (QT / CL);
        if (QT < NT && T >= lo && T <= QT) {
            const int c = T - (QT - 4);
            const LAS unsigned char* kim = ring + (T & (NS - 1)) * 16384; const LAS unsigned char* vim = kim + 8192;
            f32x16 s;
#pragma unroll
            for (int e = 0; e < 16; ++e) s[e] = 0.f;
#pragma unroll
            for (int kh = 0; kh < 4; ++kh) { bf16x8 kf[2], qq[2];
#pragma unroll
                for (int ks = 0; ks < 2; ++ks) { const int so = ((2 * (2 * kh + ks)) ^ kg0) << 4; kf[ks] = *(const LAS bf16x8*)(kim + qi * 256 + so); qq[ks] = *(const LAS bf16x8*)(qim + qi * 256 + so); }
                __builtin_amdgcn_sched_barrier(0);
#pragma unroll
                for (int ks = 0; ks < 2; ++ks) s = __builtin_amdgcn_mfma_f32_32x32x16_bf16(kf[ks], qq[ks], s, 0, 0, 0); }
            if (c == 0) {
#pragma unroll
                for (int e = 0; e < 16; ++e) if (crow(e, hh) < qi) s[e] = -1e30f;
            }
            if (c == 4) {
#pragma unroll
                for (int e = 0; e < 16; ++e) if (crow(e, hh) > qi) s[e] = -1e30f;
            }
            float mx = s[0];
#pragma unroll
            for (int e = 1; e < 16; ++e) mx = fmaxf(mx, s[e]);
            mx = fmaxf(mx, __shfl_xor(mx, 32));
            const bool grew = mx > mrun + 6.f; const float mn = grew ? mx : mrun, alpha = __builtin_amdgcn_exp2f(mrun - mn); mrun = mn;
            float ps = 0.f;
#pragma unroll
            for (int e = 0; e < 16; ++e) { s[e] = __builtin_amdgcn_exp2f(s[e] - mn); ps += s[e]; }
            l = l * alpha + ps;
            if (__any(grew)) {
#pragma unroll
                for (int dt = 0; dt < 4; ++dt)
#pragma unroll
                    for (int e = 0; e < 16; ++e) o[dt][e] *= alpha; }
            bf16x8 pb[2];
#pragma unroll
            for (int st = 0; st < 2; ++st) { v4u pk; pk.x = cvt_pk_bf16(s[8 * st + 0], s[8 * st + 1]); pk.y = cvt_pk_bf16(s[8 * st + 2], s[8 * st + 3]); pk.z = cvt_pk_bf16(s[8 * st + 4], s[8 * st + 5]); pk.w = cvt_pk_bf16(s[8 * st + 6], s[8 * st + 7]);
                pb[st] = __builtin_bit_cast(bf16x8, pk); }
#pragma unroll
            for (int dp = 0; dp < 2; ++dp) { s16x4 tv[2][2][2];
#pragma unroll
                for (int d2 = 0; d2 < 2; ++d2)
#pragma unroll
                    for (int st = 0; st < 2; ++st)
#pragma unroll
                        for (int e = 0; e < 2; ++e) { const int dt = 2 * dp + d2, row = 16 * st + 8 * e + 4 * hh + q4; const int chunk = 4 * dt + 2 * (G16 & 1) + (p4 >> 1);
                            tv[d2][st][e] = __builtin_amdgcn_ds_read_tr16_b64_v4i16((LAS s16x4*)(vim + row * 256 + ((chunk ^ swzf(row)) << 4) + (p4 & 1) * 8)); }
                __builtin_amdgcn_sched_barrier(0);
#pragma unroll
                for (int d2 = 0; d2 < 2; ++d2)
#pragma unroll
                    for (int st = 0; st < 2; ++st) { const bf16x8 va = __builtin_shufflevector(tv[d2][st][0], tv[d2][st][1], 0, 1, 2, 3, 4, 5, 6, 7);
                        o[2 * dp + d2] = __builtin_amdgcn_mfma_f32_32x32x16_bf16(va, pb[st], o[2 * dp + d2], 0, 0, 0); } }
            if (T == QT) k = 0;
        } else if (k == 1) { if (PIDX == 2) SL_M1(); else SL_FINAL(); }
        else if (k == 2) { if (PIDX == 2) SL_M2(); QT += 8; if (QT < NT) SL_QLOAD(QT); }
        ++k;
    }
    if (PIDX == 2) { if (k == 1) { SL_M1(); SL_M2(); } else if (k == 2) { SL_M2(); } }
    else if (k == 1) { SL_FINAL(); }
    asm volatile("s_waitcnt vmcnt(0) lgkmcnt(0)" ::: "memory"); __builtin_amdgcn_s_barrier(); asm volatile("" ::: "memory");
#undef SL_STAGE
#undef SL_QLOAD
#undef SL_FINAL
#undef SL_M1
#undef SL_M2
}
__device__ __forceinline__ void attn_unit_bh(Frame& F, int b, int h, int slot) {
    const bf16* kvb = (const bf16*)F.out + (size_t)(b * NHEAD + h) * SEQ * HD;
    float* lsc = (float*)(F.ws + WS_U) + (size_t)slot * 8192;
    bf16* base = F.row + (size_t)b * SEQ * RB + h * 128;
    attn_slide<0>(F, base, kvb, lsc, nullptr);
    attn_slide<1>(F, base, kvb, lsc + 2048, nullptr);
    __syncthreads();
    attn_slide<2>(F, base, kvb, lsc + 4096, nullptr);
    __syncthreads();
}
__device__ __forceinline__ void convert_queue(Frame& F, int cw, int lo, int hi) {
    volatile LAS int* slot = (volatile LAS int*)(F.lds + TAB_OFF + 512);
    LAS float* scr = (LAS float*)(F.lds + F.wave * 16384);
    for (;;) {
        __syncthreads();
        if (F.tid == 0) slot[0] = lo + (int)__hip_atomic_fetch_add(F.ctl + cw, 1u, RLX_AGENT);
        __syncthreads();
        const int it = slot[0];
        if (it >= hi) break;
        { const float* src; int N; bf16* dst; int dK; f32x4 va[8], vb[8];
          expert_item_addr(F, it * 64 + F.wave * 8, src, N, dst, dK); tr_load<true>(src, N, F.lane, va);
#pragma unroll 1
          for (int j = 0; j < 8; j += 2) {
              const float* s1; int N1; bf16* d1; int dK1; expert_item_addr(F, it * 64 + F.wave * 8 + j + 1, s1, N1, d1, dK1); tr_load<true>(s1, N1, F.lane, vb);
              tr_finish<true>(va, dst, dK, scr, F.lane);
              if (j + 2 < 8) { expert_item_addr(F, it * 64 + F.wave * 8 + j + 2, src, N, dst, dK); tr_load<true>(src, N, F.lane, va); }
              tr_finish<true>(vb, d1, dK1, scr, F.lane);
          } }
    }
    __syncthreads();
}
__device__ __forceinline__ void p3_phase(Frame& F) {
    volatile LAS int* slot = (volatile LAS int*)(F.lds + TAB_OFF);
    for (;;) {
        __syncthreads();
        if (F.tid == 0) slot[0] = (int)__hip_atomic_fetch_add(F.ctl + CW_QUEUE, 1u, RLX_AGENT);
        __syncthreads();
        const int it = slot[0];
        if (it >= 128) break;
        hgrn_unit2(F, it >> 4, it & 15);
    }
    for (;;) {
        __syncthreads();
        if (F.tid == 0) slot[0] = (int)__hip_atomic_fetch_add(F.ctl + CW_QUEUE + 64, 1u, RLX_AGENT);
        __syncthreads();
        const int it = slot[0];
        if (it >= 128) break;
        attn_unit_bh(F, it >> 4, it & 15, it);
    }
    convert_queue(F, CW_QUEUE + 128, 0, 1024);
}

__device__ __forceinline__ void p6_phase(Frame& F) {
    LAS float* sh = (LAS float*)F.lds; LAS float* sg = sh + 2048; LAS float* SS = sg + 2048; LAS float* LG = SS + 128;
    LAS int* HI = (LAS int*)(LG + 8 * 16 * 48);
    const float* rowf = (const float*)F.row;
    const int lane = F.lane, w = F.wave, l15 = lane & 15, g = lane >> 4, rg = w >> 1, kh = w & 1;
    const bf16* rwh = (const bf16*)F.rwt; const bf16* rwl = rwh + 48 * 2048;
    for (int rb = F.vcu; rb < 256; rb += F.G) {
        const int b = rb >> 5;
        __syncthreads();
        for (int k = F.tid; k < 2048; k += 512) { sh[k] = F.modf[b * 12288 + 3 * D + k]; sg[k] = (1.f + F.modf[b * 12288 + 4 * D + k]) * F.ffn_g[k]; }
        if (F.tid < 32) HI[F.tid] = 0;
        __syncthreads();
        const int row = rb * 64 + rg * 16 + l15;
        const GAS float* hp = (const GAS float*)F.x + (size_t)row * D + kh * 1024 + 8 * g;
        const GAS bf16* dp = (const GAS bf16*)F.row + (size_t)row * RB + S_HF + kh * 1024 + 8 * g;
        float s = 0.f;
#pragma unroll 8
        for (int kk = 0; kk < 32; ++kk) { f32x4 a = *(const GAS f32x4*)(hp + 32 * kk), c = *(const GAS f32x4*)(hp + 32 * kk + 4); const v4u dv = *(const GAS v4u*)(dp + 32 * kk);
            a += (f32x4){bflo(dv.x), bfhi(dv.x), bflo(dv.y), bfhi(dv.y)}; c += (f32x4){bflo(dv.z), bfhi(dv.z), bflo(dv.w), bfhi(dv.w)};
            s += ((a.x * a.x + a.y * a.y) + (a.z * a.z + a.w * a.w)) + ((c.x * c.x + c.y * c.y) + (c.z * c.z + c.w * c.w)); }
        s += __shfl_xor(s, 16); s += __shfl_xor(s, 32);
        if (g == 0) SS[w * 16 + l15] = s;
        __syncthreads();
        const float rstd = rsqrtf((SS[w * 16 + l15] + SS[(w ^ 1) * 16 + l15]) * (1.f / D) + 1e-6f);
        f32x4 acc[3];
#pragma unroll
        for (int nt = 0; nt < 3; ++nt) acc[nt] = (f32x4){0.f, 0.f, 0.f, 0.f};
        LAS unsigned char* WL = (LAS unsigned char*)(HI + 64);
        const GAS float* xr = (const GAS float*)F.x + (size_t)row * D + 8 * g;
        const GAS bf16* dr = (const GAS bf16*)F.row + (size_t)row * RB + S_HF + 8 * g;
        bf16* ur = F.row + (size_t)row * RB + S_U2 + 8 * g;
        for (int c = 0; c < 4; ++c) {
            f32x4 xa[8], xc[8]; v4u dv[8];
#pragma unroll
            for (int kk = 0; kk < 8; ++kk) { const int ko = 512 * c + 256 * kh + 32 * kk; xa[kk] = *(const GAS f32x4*)(xr + ko); xc[kk] = *(const GAS f32x4*)(xr + ko + 4); dv[kk] = *(const GAS v4u*)(dr + ko); }
            __syncthreads();
#pragma unroll
            for (int p = 0; p < 12; ++p) { const int idx = F.tid + 512 * p, hl = idx / 3072, rem = idx % 3072, n = rem >> 6, pc = rem & 63;
                const v4u wv = *(const GAS v4u*)(rwh + (size_t)hl * (48 * 2048) + (size_t)n * D + 512 * c + 8 * pc); *(LAS v4u*)(WL + hl * 49920 + n * 1040 + pc * 16) = wv; }
            __syncthreads();
#pragma unroll
            for (int kk = 0; kk < 8; ++kk) {
                const int kl = 256 * kh + 32 * kk + 8 * g, k0 = 512 * c + kl;
                const f32x4 a = xa[kk] + (f32x4){bflo(dv[kk].x), bfhi(dv[kk].x), bflo(dv[kk].y), bfhi(dv[kk].y)}, cc = xc[kk] + (f32x4){bflo(dv[kk].z), bfhi(dv[kk].z), bflo(dv[kk].w), bfhi(dv[kk].w)};
                const f32x4 u0 = a * rstd * *(const LAS f32x4*)(sg + k0) + *(const LAS f32x4*)(sh + k0), u1 = cc * rstd * *(const LAS f32x4*)(sg + k0 + 4) + *(const LAS f32x4*)(sh + k0 + 4);
                v4u hi; hi.x = pk2(u0.x, u0.y); hi.y = pk2(u0.z, u0.w); hi.z = pk2(u1.x, u1.y); hi.w = pk2(u1.z, u1.w);
                v4u lo; lo.x = pk2(u0.x - bflo(hi.x), u0.y - bfhi(hi.x)); lo.y = pk2(u0.z - bflo(hi.y), u0.w - bfhi(hi.y)); lo.z = pk2(u1.x - bflo(hi.z), u1.y - bfhi(hi.z)); lo.w = pk2(u1.z - bflo(hi.w), u1.w - bfhi(hi.w));
                *(GAS v4u*)(ur + (k0 - 8 * g)) = hi;
                const bf16x8 ah = __builtin_bit_cast(bf16x8, hi), al = __builtin_bit_cast(bf16x8, lo);
#pragma unroll
                for (int nt = 0; nt < 3; ++nt) { const bf16x8 bh = *(const LAS bf16x8*)(WL + (nt * 16 + l15) * 1040 + kl * 2), bl = *(const LAS bf16x8*)(WL + 49920 + (nt * 16 + l15) * 1040 + kl * 2);
                    acc[nt] = __builtin_amdgcn_mfma_f32_16x16x32_bf16(ah, bh, acc[nt], 0, 0, 0); acc[nt] = __builtin_amdgcn_mfma_f32_16x16x32_bf16(ah, bl, acc[nt], 0, 0, 0); acc[nt] = __builtin_amdgcn_mfma_f32_16x16x32_bf16(al, bh, acc[nt], 0, 0, 0); }
            }
        }
#pragma unroll
        for (int nt = 0; nt < 3; ++nt)
#pragma unroll
            for (int r = 0; r < 4; ++r) LG[(w * 16 + 4 * g + r) * 48 + nt * 16 + l15] = acc[nt][r];
        __syncthreads();
        if (kh == 0 && lane < 16) {
            LAS float* q0 = LG + (w * 16 + lane) * 48; const LAS float* q1 = LG + ((w + 1) * 16 + lane) * 48; const int tok = rb * 64 + rg * 16 + lane;
            for (int i = 0; i < 36; ++i) q0[i] = q0[i] + q1[i] + (i < 32 ? F.re_b[i] : F.rg_b[i - 32]);
            int gs = 0; float gm = q0[32];
            for (int gg = 1; gg < 4; ++gg) if (q0[32 + gg] > gm) { gm = q0[32 + gg]; gs = gg; }
            float gden = 0.f; for (int gg = 0; gg < 4; ++gg) gden += __expf(q0[32 + gg] - gm);
            const float pg = 1.f / gden;
            const LAS float* le = q0 + gs * 8;
            int i0 = 0; float m0 = le[0];
            for (int i = 1; i < 8; ++i) if (le[i] > m0) { m0 = le[i]; i0 = i; }
            int i1 = (i0 + 1) & 7; float m1 = -3.0e38f;
            for (int i = 0; i < 8; ++i) if (i != i0 && le[i] > m1) { m1 = le[i]; i1 = i; }
            const float e1 = __expf(m1 - m0), wt0 = pg / (1.f + e1), wt1 = pg * e1 / (1.f + e1);
            F.tokw[tok * 2] = wt0; F.tokw[tok * 2 + 1] = wt1;
            const int ea = gs * 8 + i0, eb = gs * 8 + i1;
            const int pa = __hip_atomic_fetch_add(HI + ea, 1, __ATOMIC_RELAXED, __HIP_MEMORY_SCOPE_WORKGROUP); F.list[(rb * 32 + ea) * 64 + pa] = tok * 2;
            const int pb = __hip_atomic_fetch_add(HI + eb, 1, __ATOMIC_RELAXED, __HIP_MEMORY_SCOPE_WORKGROUP); F.list[(rb * 32 + eb) * 64 + pb] = tok * 2 + 1;
        }
        __syncthreads();
        if (F.tid < 32) F.cntw[rb * 32 + F.tid] = HI[F.tid];
    }
}
constexpr int PRE_OFF = PRE_OFF_;
__device__ __forceinline__ void moe_table(Frame& F) {
    volatile LAS int* tab = (volatile LAS int*)(F.lds + TAB_OFF);
    LAS unsigned short* PRE = (LAS unsigned short*)(F.lds + PRE_OFF);
    LAS int* SEG = (LAS int*)(F.lds + PRE_OFF + 16384);
    __syncthreads();
    const int e = F.tid & 31, seg = F.tid >> 5;
    int c[16]; int ssum = 0;
#pragma unroll
    for (int i = 0; i < 16; ++i) { c[i] = ((const GAS int*)F.cntw)[(seg * 16 + i) * 32 + e]; }
#pragma unroll
    for (int i = 0; i < 16; ++i) ssum += c[i];
    SEG[seg * 32 + e] = ssum;
    __syncthreads();
    int off = 0, tot = 0;
#pragma unroll
    for (int q = 0; q < 16; ++q) { const int z = SEG[q * 32 + e]; off += (q < seg) ? z : 0; tot += z; }
#pragma unroll
    for (int i = 0; i < 16; ++i) { PRE[e * 256 + seg * 16 + i] = (unsigned short)off; off += c[i]; }
    if (seg == 0) tab[e] = tot;
    __syncthreads();
    if (F.tid == 0) { int base = 0;
        for (int k = 0; k < 32; ++k) { tab[32 + k] = base; base += (tab[k] + 255) >> 8; }
        tab[64] = base; }
    __syncthreads();
}
__device__ __forceinline__ void p9_phase(Frame& F) {
    LAS float* gf = (LAS float*)F.lds; LAS float* fg = gf + 2048;
    const float* rowf = (const float*)F.row;
    for (int rb = F.vcu; rb < 256; rb += F.G) {
        const int b = rb >> 5;
        __syncthreads();
        for (int k = F.tid; k < 2048; k += 512) { gf[k] = F.modf[b * 12288 + 5 * D + k]; fg[k] = F.fin_g[k]; }
        __syncthreads();
        for (int r = 0; r < 8; ++r) {
            const int row = rb * 64 + F.wave * 8 + r;
            const GAS f32x4* hr = (const GAS f32x4*)(F.x + (size_t)row * D) + F.lane; const GAS v2u* dl = (const GAS v2u*)(F.row + (size_t)row * RB + S_HF) + F.lane;
            const GAS v2u* y0 = (const GAS v2u*)(F.row + (size_t)row * RB + S_Y0) + F.lane; const GAS v2u* y1 = (const GAS v2u*)(F.row + (size_t)row * RB + S_Y1) + F.lane;
            const float w0 = F.tokw[row * 2], w1 = F.tokw[row * 2 + 1];
            f32x4 v[8]; float s = 0.f;
#pragma unroll
            for (int j = 0; j < 8; ++j) { const v2u dd = dl[64 * j]; const f32x4 hvv = hr[64 * j] + (f32x4){bflo(dd.x), bfhi(dd.x), bflo(dd.y), bfhi(dd.y)}; const v2u a = y0[64 * j], c = y1[64 * j]; const f32x4 g4 = *(const LAS f32x4*)(gf + 4 * (F.lane + 64 * j));
                const f32x4 f = {w0 * bflo(a.x) + w1 * bflo(c.x), w0 * bfhi(a.x) + w1 * bfhi(c.x), w0 * bflo(a.y) + w1 * bflo(c.y), w0 * bfhi(a.y) + w1 * bfhi(c.y)};
                v[j] = hvv + g4 * f; s += (v[j].x * v[j].x + v[j].y * v[j].y) + (v[j].z * v[j].z + v[j].w * v[j].w); }
            const float rstd = rsqrtf(wave_sum(s) * (1.f / D) + 1e-6f);
            GAS f32x4* op = (GAS f32x4*)(F.out + (size_t)row * D) + F.lane;
#pragma unroll
            for (int j = 0; j < 8; ++j) op[64 * j] = v[j] * rstd * *(const LAS f32x4*)(fg + 4 * (F.lane + 64 * j));
        }
    }
}

struct Args { const void* in[21]; float* out; unsigned char* ws; int ph_lo, ph_hi; };
__global__ void __launch_bounds__(512, 2) mk_fwd(Args args) {
    extern __shared__ __attribute__((aligned(16))) unsigned char lds[];
    Frame F;
    F.lds = (LAS unsigned char*)lds;
    F.MISC = (volatile LAS unsigned*)(F.lds + MISC_OFF);
    F.tid = threadIdx.x; F.lane = F.tid & 63; F.wave = __builtin_amdgcn_readfirstlane(F.tid >> 6);
    F.G = gridDim.x; { const int bx = blockIdx.x; F.vcu = (F.G % 8 == 0) ? (bx % 8) * (F.G / 8) + bx / 8 : bx; }
    unsigned char* ws = args.ws; F.ws = ws;
    F.ctl = (gu32*)(ws + WS_CTL);
    F.x = (const float*)args.in[0]; F.c = (const float*)args.in[1]; F.pos = (const int*)args.in[2]; F.ada_w = (const float*)args.in[3]; F.ada_b = (const float*)args.in[4];
    F.mix_g = (const float*)args.in[5]; F.w_in = (const float*)args.in[6]; F.w_a = (const float*)args.in[7]; F.w_r = (const float*)args.in[8]; F.w_o = (const float*)args.in[9];
    F.rec_g = (const float*)args.in[10]; F.lbl = (const float*)args.in[11]; F.ffn_g = (const float*)args.in[12]; F.rg_w = (const float*)args.in[13]; F.rg_b = (const float*)args.in[14];
    F.re_w = (const float*)args.in[15]; F.re_b = (const float*)args.in[16]; F.e_gate = (const float*)args.in[17]; F.e_up = (const float*)args.in[18]; F.e_down = (const float*)args.in[19];
    F.fin_g = (const float*)args.in[20]; F.out = args.out;
    F.modp = (float*)(ws + WS_MODP); F.modf = (float*)(ws + WS_MODF); F.lb = (float*)(ws + WS_LB); F.rwt = (float*)(ws + WS_RWT); F.tokw = (float*)(ws + WS_TOKW); F.list = (int*)(ws + WS_LIST); F.cntw = (int*)(ws + WS_CNTW);
    F.win_t = (bf16*)(ws + WS_WIN); F.wa_t = (bf16*)(ws + WS_WA); F.wr_t = (bf16*)(ws + WS_WR); F.wo_t = (bf16*)(ws + WS_WO); F.w1_t = (bf16*)(ws + WS_W1); F.w2_t = (bf16*)(ws + WS_W2);
    F.U = (bf16*)(ws + WS_U); F.hdn = (bf16*)(ws + WS_U); F.row = (bf16*)(ws + WS_ROW);
    for (int u = F.tid; u < (LDS_BYTES - LDSCTL_OFF) / 4; u += 512) ((LAS unsigned*)(F.lds + LDSCTL_OFF))[u] = 0u;
    __syncthreads();
    XcdBarrier bar; bar.bar = (unsigned*)(F.ctl + CW_BAR); bar.x = 0; bar.st = nullptr;
    if (MK_N_LAUNCHES == 1) bar = xcd_barrier_post((unsigned*)(F.ctl + CW_BAR), F.MISC + 8);
#define GRID_BAR(seam) do { if (MK_N_LAUNCHES != 1) { if (F.tid == 0) __hip_atomic_store(F.ctl + CW_TMO, 0xBADBA0u | (unsigned)(seam), RLX_AGENT); } else { xcd_barrier(bar); } } while (0)
    const int lo = args.ph_lo, hi = args.ph_hi;
#define IN(k) (lo <= (k) && (k) < hi)
#define BOTH(k) (IN(k) && IN((k) + 1))

    if (IN(0)) { p0_phase(F); if (BOTH(0)) GRID_BAR(0); }
    if (IN(1)) { p1_phase(F); if (BOTH(1)) GRID_BAR(1); }
    if (IN(2)) {
        pg8::DenseOrder S; S.init(F.U, F.win_t, D, D, T, RB, F.G, (int)blockIdx.x);
        EpiProj E{F.row, F.pos, (bf16*)F.out};
        pg8::gemm_phase<EpiProj, pg8::DenseOrder, false>(F.lds, D, D, S, E);
        if (BOTH(2)) GRID_BAR(2);
    }
    if (IN(3)) { p3_phase(F); if (BOTH(3)) GRID_BAR(3); }
    if (IN(4)) {
        { pg8::DenseOrder S; S.init(F.row + S_YA, F.wa_t, RB, D, T, D, F.G, (int)blockIdx.x); EpiGate<0> E{F.row};
          pg8::gemm_phase<EpiGate<0>, pg8::DenseOrder, false>(F.lds, D, RB, S, E); }
        { pg8::DenseOrder S; S.init(F.row + S_YR, F.wr_t, RB, D, T, D, F.G, (int)blockIdx.x); EpiGate<1> E{F.row};
          pg8::gemm_phase<EpiGate<1>, pg8::DenseOrder, false>(F.lds, D, RB, S, E); }
        if (BOTH(4)) GRID_BAR(4);
    }
    if (IN(5)) {
        pg8::DenseOrder S; S.init(F.row + S_MG, F.wo_t, RB, D, T, D, F.G, (int)blockIdx.x); EpiH E{F.modf, F.row};
        pg8::gemm_phase<EpiH, pg8::DenseOrder, false>(F.lds, D, RB, S, E);
        if (BOTH(5)) GRID_BAR(5);
    }
    if (IN(6)) { p6_phase(F); if (BOTH(6)) GRID_BAR(6); }
    if (IN(7)) {
        moe_table(F);
        pg8::MoeOrder S{(const LAS int*)(F.lds + TAB_OFF), (const LAS unsigned short*)(F.lds + PRE_OFF), (const char*)(F.row + S_U2), (const char*)F.w1_t, (size_t)D * D * 2, RB, D, F.list, F.G, F.vcu, true, nullptr};
        EpiSwiGLU E{F.hdn};
        pg8::gemm_phase<EpiSwiGLU, pg8::MoeOrder, true>(F.lds, D, RB, S, E);
        convert_queue(F, CW_QUEUE + 192, 1024, 1536);
        if (BOTH(7)) GRID_BAR(7);
    }
    if (IN(8)) {
        moe_table(F);
        pg8::MoeOrder S{(const LAS int*)(F.lds + TAB_OFF), (const LAS unsigned short*)(F.lds + PRE_OFF), (const char*)F.hdn, (const char*)F.w2_t, (size_t)D * EH * 2, EH, EH, F.list, F.G, F.vcu, false, (LAS int*)(F.lds + PRE_OFF + 16384 + 2048)};
        EpiScatter E{F.row, F.list, (const LAS unsigned short*)(F.lds + PRE_OFF), (const LAS int*)(F.lds + PRE_OFF + 16384 + 2048)};
        pg8::gemm_phase<EpiScatter, pg8::MoeOrder, false>(F.lds, EH, EH, S, E);
        if (BOTH(8)) GRID_BAR(8);
    }
    if (IN(9)) { p9_phase(F); }
#undef IN
#undef BOTH
}

extern "C" void kernel_launch(void* const* d_in, const int* in_sizes, int n_in, void* d_out, int out_size, void* d_ws, size_t ws_size, hipStream_t stream) {
    static int grid = 0;
    if (grid == 0) {
        if (n_in != 21 || out_size != T * D || ws_size < WS_END) { fprintf(stderr, "kernel_launch: unexpected shapes: n_in %d out %d ws %zu (need %zu)\n", n_in, out_size, ws_size, (size_t)WS_END); grid = -1; return; }
        int dev = 0, cus = 0, per_cu = 0;
        if (hipGetDevice(&dev) != hipSuccess || hipDeviceGetAttribute(&cus, hipDeviceAttributeMultiprocessorCount, dev) != hipSuccess) { grid = -1; return; }
        if (hipFuncSetAttribute((const void*)mk_fwd, hipFuncAttributeMaxDynamicSharedMemorySize, LDS_BYTES) != hipSuccess) { fprintf(stderr, "kernel_launch: hipFuncSetAttribute failed\n"); grid = -1; return; }
        if (hipOccupancyMaxActiveBlocksPerMultiprocessor(&per_cu, (const void*)mk_fwd, 512, LDS_BYTES) != hipSuccess || per_cu < 1) fprintf(stderr, "kernel_launch: occupancy query reports %d\n", per_cu);
        (void)hipGetLastError();
        grid = cus;
    }
    if (grid < 0) return;
    if (hipMemsetAsync((char*)d_ws + WS_CTL, 0, CTL_ZERO_BYTES, stream) != hipSuccess) return;
    Args a{};
    for (int i = 0; i < 21; ++i) a.in[i] = d_in[i];
    a.out = (float*)d_out; a.ws = (unsigned char*)d_ws;
    if (MK_N_LAUNCHES == 1) { a.ph_lo = 0; a.ph_hi = NPHASE; hipLaunchKernelGGL(mk_fwd, dim3(grid), dim3(512), LDS_BYTES, stream, a); }
    else for (int p = 0; p < NPHASE; ++p) { a.ph_lo = p; a.ph_hi = p + 1; hipLaunchKernelGGL(mk_fwd, dim3(grid), dim3(512), LDS_BYTES, stream, a); }
}
```

```cpp
#include <hip/hip_runtime.h>
#include <cstdio>
#include <cstdint>

#ifndef MK_N_LAUNCHES
#define MK_N_LAUNCHES 1
#endif

#define GAS __attribute__((address_space(1)))
#define LAS __attribute__((address_space(3)))
typedef unsigned short bf16;
typedef unsigned v4u __attribute__((ext_vector_type(4)));
typedef unsigned v2u __attribute__((ext_vector_type(2)));
typedef float f32x4 __attribute__((ext_vector_type(4)));
typedef float f32x16 __attribute__((ext_vector_type(16)));
typedef short bf16x8 __attribute__((ext_vector_type(8)));
typedef short s16x4 __attribute__((ext_vector_type(4)));
typedef GAS unsigned gu32;

constexpr int D = 2048, NB = 8, SEQ = 2048, T = NB * SEQ;
constexpr int NHEAD = 16, HD = 128;
constexpr int RB = 18432;
constexpr int NE = 32, EH = 1024;
constexpr int NPHASE = 10;
constexpr int S_QA = 0, S_KA = 2048, S_VA = 4096, S_QR = 6144, S_FR = 8192, S_IR = 10240, S_GR = 12288, S_GA = 14336, S_GB = 16384;
constexpr int S_YA = S_QA;
constexpr int S_MG = S_KA;
constexpr int S_YR = S_QR;
constexpr int S_HF = S_VA;
constexpr int S_U2 = S_FR;
constexpr int S_Y0 = S_IR, S_Y1 = S_GR;
constexpr int RBF = RB / 2;
constexpr size_t KV_VOFF = (size_t)NB * SEQ * D * 2;

constexpr size_t MiB = 1u << 20;
constexpr size_t WS_CTL = 0, CTL_ZERO_BYTES = 1 * MiB;
constexpr size_t WS_MODP = 1 * MiB;
constexpr size_t WS_MODF = 14 * MiB;
constexpr size_t WS_LB = 15 * MiB;
constexpr size_t WS_RWT = 15 * MiB + 64 * 1024;
constexpr size_t WS_TOKW = 16 * MiB;
constexpr size_t WS_LIST = 17 * MiB;
constexpr size_t WS_CNTW = 16 * MiB + 512 * 1024;
constexpr size_t WS_PSUM = 19 * MiB;
constexpr size_t WS_WIN = 20 * MiB;
constexpr size_t WS_WA = 92 * MiB, WS_WR = 100 * MiB, WS_WO = 108 * MiB;
constexpr size_t WS_W1 = 116 * MiB;
constexpr size_t WS_W2 = 372 * MiB;
constexpr size_t WS_WIN8 = 244 * MiB;
constexpr size_t WS_YA8 = 20 * MiB, WS_YR8 = 52 * MiB;
constexpr size_t WS_WSC = 282 * MiB, WS_USC = 283 * MiB;
constexpr size_t WS_U = 500 * MiB;
constexpr size_t WS_ROW = 608 * MiB;
constexpr size_t WS_END = 1184 * MiB;

constexpr int CW_TMO = 0, CW_CODE = 1;
constexpr int CW_QUEUE = 64;
constexpr int CW_CNT = 1024;
constexpr int CW_BAR = 4096;

constexpr int RING_BYTES = 131072;
constexpr int LDSCTL_OFF = 155648, MISC_OFF = LDSCTL_OFF + 320, TAB_OFF = LDSCTL_OFF + 1024;
constexpr int LDS_BYTES = 163840;

#define RLX_AGENT __ATOMIC_RELAXED, __HIP_MEMORY_SCOPE_AGENT
#define LDS_WAIT() asm volatile("s_waitcnt lgkmcnt(0)" ::: "memory")
#define VM_WAIT() asm volatile("s_waitcnt vmcnt(0)" ::: "memory")

__device__ __forceinline__ unsigned f2bf(float f) { unsigned u = __builtin_bit_cast(unsigned, f); return (u + 0x7fffu + ((u >> 16) & 1u)) >> 16; }
__device__ __forceinline__ unsigned pk2(float lo, float hi) { return f2bf(lo) | (f2bf(hi) << 16); }
__device__ __forceinline__ float bflo(unsigned u) { return __builtin_bit_cast(float, u << 16); }
__device__ __forceinline__ float bfhi(unsigned u) { return __builtin_bit_cast(float, u & 0xffff0000u); }
__device__ __forceinline__ unsigned cvt_pk_bf16(float lo, float hi) { unsigned r; asm volatile("v_cvt_pk_bf16_f32 %0, %1, %2" : "=v"(r) : "v"(lo), "v"(hi)); return r; }
__device__ __forceinline__ unsigned cvt_pk_bf16s(float lo, float hi) { unsigned r; asm("v_cvt_pk_bf16_f32 %0, %1, %2" : "=v"(r) : "v"(lo), "v"(hi)); return r; }
__device__ __forceinline__ float sigmoidf_(float x) { return __builtin_amdgcn_rcpf(1.f + __expf(-x)); }
__device__ __forceinline__ float siluf_(float x) { return x * __builtin_amdgcn_rcpf(1.f + __expf(-x)); }
__device__ __forceinline__ float wave_sum(float v) {
#pragma unroll
    for (int o = 1; o < 64; o <<= 1) v += __shfl_xor(v, o);
    return v;
}

__device__ __forceinline__ float wave_max(float v) {
#pragma unroll
    for (int o = 1; o < 64; o <<= 1) v = fmaxf(v, __shfl_xor(v, o));
    return v;
}
__device__ __forceinline__ unsigned pack4_i8(float a, float b, float c, float d) {
    const int ia = (int)__builtin_rintf(a), ib = (int)__builtin_rintf(b), ic = (int)__builtin_rintf(c), id = (int)__builtin_rintf(d);
    return ((unsigned)ia & 0xffu) | (((unsigned)ib & 0xffu) << 8) | (((unsigned)ic & 0xffu) << 16) | ((unsigned)id << 24);
}
constexpr float WSI = 1.f / 32.f;
constexpr int F8_SQ = 7;
constexpr int PRE_OFF_ = 131072;
__device__ __forceinline__ int moe_entry(const LAS unsigned short* PRE, const int* list, int e, int idx) {
    const LAS unsigned short* p = PRE + e * 256; int lo = 0;
#pragma unroll
    for (int st = 128; st >= 1; st >>= 1) { if ((int)p[lo + st] <= idx) lo += st; }
    return ((const GAS int*)list)[(lo * 32 + e) * 64 + (idx - (int)p[lo])];
}
__device__ __forceinline__ int moe_find(const LAS unsigned short* PRE, int e, int idx) {
    const LAS unsigned short* p = PRE + e * 256; int lo = 0;
#pragma unroll
    for (int st = 128; st >= 1; st >>= 1) { if ((int)p[lo + st] <= idx) lo += st; }
    return (lo * 32 + e) * 64 + (idx - (int)p[lo]);
}
namespace pg8 {
#define PG8_LAS __attribute__((address_space(3)))
constexpr int BM = 256, BK = 64, HALF = 128, HTB = HALF * BK * 2, STAGE_BYTES = 8 * HTB, NXCD = 8, WGM = 8;
__host__ __device__ __forceinline__ int lds_byte(int r, int c) { const int st = (r >> 4) * 2 + (c >> 5), rr = r & 15, cc = c & 31, ob = rr * 64 + cc * 2; return st * 1024 + (ob ^ (((ob >> 9) & 1) << 5)); }
__host__ __device__ __forceinline__ void stage_rc(int b, int& R, int& C) { const int st = b / 1024, sb = b % 1024, swz = sb ^ (((sb >> 9) & 1) << 5); R = (st >> 1) * 16 + swz / 64; C = (st & 1) * 32 + (swz % 64) / 2; }
__host__ __device__ __forceinline__ int perm32(int rho) { const int n = rho >> 4, i = rho & 15; return 8 * (i >> 2) + 4 * n + (i & 3); }

struct Unit { int pm, pn, e, mt, rows, par; };

struct DenseOrder {
    static constexpr bool HAS_PREP = false;
    __device__ __forceinline__ void prep(const Unit&, int) const {}
    const char* A; const char* Bt; int lda, K; int nM, nN, nwg, G, c;
    __device__ void init(const void* A_, const void* Bt_, int lda_, int K_, int M, int N, int G_, int c_) { A = (const char*)A_; Bt = (const char*)Bt_; lda = lda_; K = K_; nM = M / BM; nN = N / BM; nwg = nM * nN; G = G_; c = c_; }
    __device__ __forceinline__ bool next(int i, Unit& u) const {
        const long L = (long)i * G + c; if (L >= nwg) return false;
        int wgid = (int)L; { const int q = nwg / NXCD, r = nwg % NXCD, xcd = wgid % NXCD, off = wgid / NXCD; wgid = (xcd < r ? xcd * (q + 1) : r * (q + 1) + (xcd - r) * q) + off; }
        const int nig = WGM * nN, gid = wgid / nig, fm = gid * WGM, gsz = (nM - fm) < WGM ? (nM - fm) : WGM;
        u.pm = fm + ((wgid % nig) % gsz); u.pn = (wgid % nig) / gsz; u.e = 0; u.mt = 0; u.rows = 256; return true;
    }
    __device__ __forceinline__ const char* a_tile(const Unit& u) const { return A + (size_t)u.pm * 256 * lda * 2; }
    __device__ __forceinline__ const char* b_tile(const Unit& u) const { return Bt + (size_t)u.pn * 256 * K * 2; }
    __device__ __forceinline__ void gather(const Unit&, const int (&)[2], const int (&)[2], unsigned (&)[2][2]) const {}
};

struct MoeOrder {
    static constexpr bool HAS_PREP = true;
    const LAS int* tab;
    const LAS unsigned short* pre;
    const char* A; const char* Bt; size_t b_estride; int lda, K; const int* list; int G, c; bool gath;
    __device__ __forceinline__ bool next(int i, Unit& u) const {
        const int L = i * G + c; const int NT = tab[64];
        if (L >= NT * 8) return false;
        const int tg = L >> 3; int e = 0;
        for (int k = 0; k < 32; ++k) if (tab[32 + k + 1] <= tg) e = k + 1;
        u.pm = tg; u.pn = L & 7; u.e = e; u.mt = tg - tab[32 + e]; const int rem = tab[e] - u.mt * 256; u.rows = rem < 256 ? rem : 256; return true;
    }
    __device__ __forceinline__ const char* a_tile(const Unit& u) const { return gath ? A : A + (size_t)u.pm * 256 * lda * 2; }
    __device__ __forceinline__ const char* b_tile(const Unit& u) const { return Bt + (size_t)u.e * b_estride + (size_t)u.pn * 256 * K * 2; }
    LAS int* rowtab;
    __device__ __forceinline__ void prep(const Unit& u, int slot) const {
        if (rowtab && threadIdx.x < 256) { const int r = threadIdx.x; const int en = moe_entry(pre, list, u.e, u.mt * 256 + (r < u.rows ? r : 0)); rowtab[slot * 256 + r] = r < u.rows ? en : -1; }
    }
    __device__ __forceinline__ void gather(const Unit& u, const int (&R)[2], const int (&C)[2], unsigned (&off)[2][2]) const {
        int li[2][2], en[2][2];
#pragma unroll
        for (int h = 0; h < 2; ++h)
#pragma unroll
            for (int i = 0; i < 2; ++i) { const int r = h * 128 + R[i]; li[h][i] = moe_find(pre, u.e, u.mt * 256 + (r < u.rows ? r : 0)); }
        __builtin_amdgcn_sched_barrier(0);
#pragma unroll
        for (int h = 0; h < 2; ++h)
#pragma unroll
            for (int i = 0; i < 2; ++i) en[h][i] = ((const GAS int*)list)[li[h][i]];
        __builtin_amdgcn_sched_barrier(0);
#pragma unroll
        for (int h = 0; h < 2; ++h)
#pragma unroll
            for (int i = 0; i < 2; ++i) off[h][i] = (unsigned)(en[h][i] >> 1) * (unsigned)(lda * 2) + (unsigned)(C[i] * 2);
    }
};

typedef int i32x4_ __attribute__((ext_vector_type(4)));
typedef int i32x8_ __attribute__((ext_vector_type(8)));
template <int MODE> __device__ __forceinline__ void mma_blk(f32x4& acc, const bf16x8 (&b)[2], const bf16x8 (&a)[2]) {
    if (MODE == 1) {
        const i32x8_ bb = __builtin_shufflevector(__builtin_bit_cast(i32x4_, b[0]), __builtin_bit_cast(i32x4_, b[1]), 0, 1, 2, 3, 4, 5, 6, 7);
        const i32x8_ aa = __builtin_shufflevector(__builtin_bit_cast(i32x4_, a[0]), __builtin_bit_cast(i32x4_, a[1]), 0, 1, 2, 3, 4, 5, 6, 7);
        asm volatile("v_mfma_f32_16x16x128_f8f6f4 %0, %1, %2, %0" : "+v"(acc) : "v"(bb), "v"(aa));
    } else if (MODE == 2) {
        i32x4_ c = __builtin_bit_cast(i32x4_, acc);
        c = __builtin_amdgcn_mfma_i32_16x16x64_i8(__builtin_bit_cast(i32x4_, b[0]), __builtin_bit_cast(i32x4_, a[0]), c, 0, 0, 0);
        c = __builtin_amdgcn_mfma_i32_16x16x64_i8(__builtin_bit_cast(i32x4_, b[1]), __builtin_bit_cast(i32x4_, a[1]), c, 0, 0, 0);
        acc = __builtin_bit_cast(f32x4, c);
    } else {
        acc = __builtin_amdgcn_mfma_f32_16x16x32_bf16(b[0], a[0], acc, 0, 0, 0);
        acc = __builtin_amdgcn_mfma_f32_16x16x32_bf16(b[1], a[1], acc, 0, 0, 0);
    }
}
template <class Epi, class Sched, bool GATHER, int MODE = 0>
__device__ __forceinline__ void gemm_phase(PG8_LAS unsigned char* lds, const int K, const int lda, const Sched& S, const Epi& E) {
    const int tid = threadIdx.x, wid = __builtin_amdgcn_readfirstlane(tid >> 6), lane = tid & 63, wr = wid >> 2, wc = wid & 3, fr = lane & 15, fq = lane >> 4;
    const int nt = K / BK;
    unsigned voffA[2], voffB[2]; int RR[2], CC[2];
#pragma unroll
    for (int i = 0; i < 2; ++i) { int R, C; stage_rc(tid * 16 + i * 8192, R, C); const int Rb = Epi::PERM ? ((R & ~31) + perm32(R & 31)) : R;
        RR[i] = R; CC[i] = C; voffA[i] = (unsigned)(R * lda + C) * 2u; voffB[i] = (unsigned)(Rb * K + C) * 2u; }
    const size_t kstep = (size_t)(BK * 2);
    const size_t hstepA = (size_t)HALF * lda * 2, hstepB = (size_t)HALF * K * 2;
    const unsigned ldsw = (unsigned)wid * 1024u;
    const int aoff = lds_byte(wr * 64 + fr, fq * 8), boff = lds_byte(wc * 32 + fr, fq * 8);
#define PG8_SA(b, h) (((b) * 2 + (h)) * HTB)
#define PG8_SB(b, h) ((4 + (b) * 2 + (h)) * HTB)
#define PG8_STAGEB(bufoff, gbase) do { _Pragma("unroll") for (int _i = 0; _i < 2; ++_i) \
        __builtin_amdgcn_global_load_lds((const unsigned*)((const char*)(gbase) + voffB[_i]), (PG8_LAS unsigned*)(lds + (bufoff) + ldsw + _i * 8192), 16, 0, 0); } while (0)
#define PG8_STAGEA(bufoff, gbase, h, GO) do { const char* _p = (const char*)(gbase) + (GATHER ? (size_t)0 : (size_t)(h) * hstepA); _Pragma("unroll") for (int _i = 0; _i < 2; ++_i) \
        __builtin_amdgcn_global_load_lds((const unsigned*)(_p + (GATHER ? GO[h][_i] : voffA[_i])), (PG8_LAS unsigned*)(lds + (bufoff) + ldsw + _i * 8192), 16, 0, 0); } while (0)
#define PG8_LDA(dst, b, h) do { _Pragma("unroll") for (int m = 0; m < 4; ++m) _Pragma("unroll") for (int k = 0; k < 2; ++k) dst[m][k] = *(const PG8_LAS bf16x8*)(lds + PG8_SA(b, h) + aoff + m * 2048 + k * 1024); } while (0)
#define PG8_LDB(dst, b, h) do { _Pragma("unroll") for (int n = 0; n < 2; ++n) _Pragma("unroll") for (int k = 0; k < 2; ++k) dst[n][k] = *(const PG8_LAS bf16x8*)(lds + PG8_SB(b, h) + boff + n * 2048 + k * 1024); } while (0)
#define PG8_MMA(ai, bj, At, Bt) do { __builtin_amdgcn_s_setprio(1); _Pragma("unroll") for (int m = 0; m < 4; ++m) _Pragma("unroll") for (int n = 0; n < 2; ++n) \
        mma_blk<MODE>(acc[ai][bj][m][n], Bt[n], At[m]); __builtin_amdgcn_s_setprio(0); } while (0)
#define PG8_WAIT_V(n) asm volatile("s_waitcnt vmcnt(" #n ")" ::: "memory")
#define PG8_WAIT_L(n) asm volatile("s_waitcnt lgkmcnt(" #n ")" ::: "memory")
#define PG8_BAR __builtin_amdgcn_s_barrier()
#define PG8_SCHED __builtin_amdgcn_sched_barrier(0)
    Unit cur, nxt; int ui = 0;
    if (!S.next(0, cur)) return;
    f32x4 acc[2][2][4][2];
#pragma unroll
    for (int a = 0; a < 2; ++a)
#pragma unroll
        for (int b = 0; b < 2; ++b)
#pragma unroll
            for (int m = 0; m < 4; ++m)
#pragma unroll
                for (int n = 0; n < 2; ++n) acc[a][b][m][n] = (f32x4){0.f, 0.f, 0.f, 0.f};
    bf16x8 At[4][2], B0[2][2], B1[2][2];
    unsigned gc[2][2] = {{0u, 0u}, {0u, 0u}}, gn[2][2] = {{0u, 0u}, {0u, 0u}};
    const char* cA = S.a_tile(cur); const char* cB = S.b_tile(cur);
    if (GATHER) { S.gather(cur, RR, CC, gc); }
    if (Sched::HAS_PREP) S.prep(cur, 0);
    typedef float f32x2_ __attribute__((ext_vector_type(2)));
    f32x2_ epre = {0.f, 0.f}; if constexpr (Epi::HAS_PRE) epre = E.pre(cur);
    PG8_STAGEB(PG8_SB(0, 0), cB); PG8_STAGEB(PG8_SB(0, 1), cB + hstepB); PG8_STAGEA(PG8_SA(0, 0), cA, 0, gc); PG8_STAGEA(PG8_SA(0, 1), cA, 1, gc);
    if (wr == 1) PG8_BAR;
    PG8_WAIT_V(2); PG8_BAR;
    PG8_STAGEB(PG8_SB(1, 0), cB + kstep); PG8_STAGEA(PG8_SA(1, 0), cA + kstep, 0, gc); PG8_STAGEB(PG8_SB(1, 1), cB + hstepB + kstep);
    PG8_WAIT_V(6); PG8_BAR;
    for (;;) {
        const bool has_next = S.next(ui + 1, nxt);
        const char* nA = has_next ? S.a_tile(nxt) : cA; const char* nB = has_next ? S.b_tile(nxt) : cB;
        if (Sched::HAS_PREP) { if (has_next) S.prep(nxt, (ui + 1) & 1); }
        if (GATHER) { if (has_next) S.gather(nxt, RR, CC, gn); else {
#pragma unroll
            for (int h = 0; h < 2; ++h)
#pragma unroll
                for (int i = 0; i < 2; ++i) gn[h][i] = gc[h][i]; } }
        for (int t = 0; t < nt; t += 2) {
            const bool last = (t == nt - 2);
            const char* a1 = cA + (size_t)(t + 1) * kstep;
            const char* a2 = last ? nA : cA + (size_t)(t + 2) * kstep; const char* b2 = last ? nB : cB + (size_t)(t + 2) * kstep;
            const char* a3 = a2 + kstep; const char* b3 = b2 + kstep;
            unsigned g2[2][2];
#pragma unroll
            for (int h = 0; h < 2; ++h)
#pragma unroll
                for (int i = 0; i < 2; ++i) g2[h][i] = last ? gn[h][i] : gc[h][i];
            PG8_LDB(B0, 0, 0); PG8_LDB(B1, 0, 1); PG8_SCHED; PG8_LDA(At, 0, 0); PG8_STAGEA(PG8_SA(1, 1), a1, 1, gc);
            PG8_WAIT_V(8); PG8_WAIT_L(0); PG8_BAR; PG8_MMA(0, 0, At, B0); PG8_MMA(0, 1, At, B1); PG8_BAR; PG8_SCHED;
            PG8_LDA(At, 0, 1); PG8_STAGEB(PG8_SB(0, 0), b2); PG8_STAGEB(PG8_SB(0, 1), b2 + hstepB); PG8_STAGEA(PG8_SA(0, 0), a2, 0, g2);
            PG8_WAIT_V(8); PG8_WAIT_L(0); PG8_BAR; PG8_MMA(1, 0, At, B0); PG8_MMA(1, 1, At, B1); PG8_BAR; PG8_SCHED;
            PG8_LDB(B0, 1, 0); PG8_LDB(B1, 1, 1); PG8_SCHED; PG8_LDA(At, 1, 0); PG8_STAGEA(PG8_SA(0, 1), a2, 1, g2);
            PG8_WAIT_V(8); PG8_WAIT_L(0); PG8_BAR; PG8_MMA(0, 0, At, B0); PG8_MMA(0, 1, At, B1); PG8_BAR; PG8_SCHED;
            PG8_LDA(At, 1, 1); PG8_STAGEB(PG8_SB(1, 0), b3); PG8_STAGEB(PG8_SB(1, 1), b3 + hstepB); PG8_STAGEA(PG8_SA(1, 0), a3, 0, g2);
            PG8_WAIT_V(8); PG8_WAIT_L(0); PG8_BAR; PG8_MMA(1, 0, At, B0); PG8_MMA(1, 1, At, B1); PG8_BAR; PG8_SCHED;
        }
        if (wr == 0) PG8_BAR;
        cur.par = ui & 1;
        if (MODE == 1) { asm volatile("s_nop 15\n\ts_nop 15" ::: "memory"); }
        if constexpr (Epi::HAS_PRE) E(acc, cur, wr, wc, fr, fq, epre); else E(acc, cur, wr, wc, fr, fq);
        if (!has_next) break;
#pragma unroll
        for (int a = 0; a < 2; ++a)
#pragma unroll
            for (int b = 0; b < 2; ++b)
#pragma unroll
                for (int m = 0; m < 4; ++m)
#pragma unroll
                    for (int n = 0; n < 2; ++n) acc[a][b][m][n] = (f32x4){0.f, 0.f, 0.f, 0.f};
        cur = nxt; cA = nA; cB = nB; ++ui;
        if constexpr (Epi::HAS_PRE) epre = E.pre(cur);
        if (GATHER) {
#pragma unroll
            for (int h = 0; h < 2; ++h)
#pragma unroll
                for (int i = 0; i < 2; ++i) gc[h][i] = gn[h][i]; }
        if (wr == 1) PG8_BAR;
    }
    PG8_WAIT_V(0);
    PG8_BAR;
#undef PG8_SA
#undef PG8_SB
#undef PG8_STAGEA
#undef PG8_STAGEB
#undef PG8_LDA
#undef PG8_LDB
#undef PG8_MMA
#undef PG8_WAIT_V
#undef PG8_WAIT_L
#undef PG8_BAR
#undef PG8_SCHED
}
}

#define XB_TMO      128
#define XB_XCNT(j)  (256  + 64 * (j))
#define XB_XSUB(j)  (1280 + 64 * (j))
#define XB_XGEN(j)  (2304 + 64 * (j))
#define XB_TOP      3328
#define XB_TOPGEN   3392
#define XCD_BAR_WORDS 3456
#define XB_SPIN_CAP (1u << 18)
__device__ __forceinline__ unsigned xb_ld(unsigned* p)              { return __hip_atomic_load(p, __ATOMIC_RELAXED, __HIP_MEMORY_SCOPE_AGENT); }
__device__ __forceinline__ unsigned xb_add(unsigned* p, unsigned v) { return __hip_atomic_fetch_add(p, v, __ATOMIC_RELAXED, __HIP_MEMORY_SCOPE_AGENT); }
__device__ __forceinline__ unsigned xb_xcc_id() { return (unsigned)__builtin_amdgcn_s_getreg((3 << 11) | 20) & 0xFu; }
#define XB_SPIN(cond, bar) do { unsigned _sp = 0; while (cond) { __builtin_amdgcn_s_sleep(1); \
    if ((++_sp & 255u) == 0u) { if (xb_ld(&(bar)[XB_TMO])) break; if (_sp > XB_SPIN_CAP) { atomicAdd(&(bar)[XB_TMO], 1u); break; } } } } while (0)
struct XcdBarrier { unsigned* bar; unsigned x; volatile LAS unsigned* st; };
__device__ __forceinline__ XcdBarrier xcd_barrier_post(unsigned* bar, volatile LAS unsigned* st) {
    XcdBarrier b; b.bar = bar; b.x = xb_xcc_id(); b.st = st;
    if (threadIdx.x == 0) (void)xb_add(&bar[XB_XCNT(b.x)], 1u);
    return b;
}
__device__ __forceinline__ void xcd_barrier_complete(unsigned* bar, unsigned x, unsigned& nloc, unsigned& nx) {
    const unsigned G = gridDim.x * gridDim.y * gridDim.z;
    unsigned sum, cnt, mine, sp = 0u;
    for (;;) {
        sum = 0u; cnt = 0u; mine = 0u;
#pragma unroll
        for (unsigned j = 0; j < 16; ++j) { const unsigned c = xb_ld(&bar[XB_XCNT(j)]); sum += c; cnt += (c > 0u) ? 1u : 0u; mine = (j == x) ? c : mine; }
        if (sum == G) break;
        __builtin_amdgcn_s_sleep(1);
        if ((++sp & 255u) == 0u) { if (xb_ld(&bar[XB_TMO])) break; if (sp > XB_SPIN_CAP) { atomicAdd(&bar[XB_TMO], 1u); break; } }
    }
    nloc = mine > 0u ? mine : 1u; nx = cnt > 0u ? cnt : 1u;
}
__device__ __forceinline__ void xcd_barrier(const XcdBarrier& b) {
    asm volatile("s_waitcnt vmcnt(0)" ::: "memory");
    __syncthreads();
    if (threadIdx.x == 0) {
        unsigned* bar = b.bar;
        __builtin_amdgcn_s_waitcnt(0);
        unsigned nloc = b.st[0], nx = b.st[1];
        if (nloc == 0u) { xcd_barrier_complete(bar, b.x, nloc, nx); b.st[0] = nloc; b.st[1] = nx; }
        const unsigned old = xb_add(&bar[XB_XSUB(b.x)], 1u);
        const unsigned gen = old / nloc;
        if (old + 1u == (gen + 1u) * nloc) {
            __builtin_amdgcn_fence(__ATOMIC_RELEASE, "agent");
            asm volatile("s_waitcnt vmcnt(0)" ::: "memory");
            const unsigned og = xb_add(&bar[XB_TOP], 1u);
            const unsigned tg = og / nx;
            if (og + 1u == (tg + 1u) * nx) xb_add(&bar[XB_TOPGEN], 1u);
            else XB_SPIN(xb_ld(&bar[XB_TOPGEN]) == tg, bar);
            __builtin_amdgcn_fence(__ATOMIC_ACQUIRE, "agent");
            xb_add(&bar[XB_XGEN(b.x)], 1u);
            asm volatile("s_waitcnt vmcnt(0)" ::: "memory");
        } else {
            XB_SPIN(xb_ld(&bar[XB_XGEN(b.x)]) == gen, bar);
            __builtin_amdgcn_fence(__ATOMIC_ACQUIRE, "agent");
            asm volatile("s_waitcnt vmcnt(0)" ::: "memory");
        }
    }
    __syncthreads();
}

struct Frame {
    LAS unsigned char* lds;
    volatile LAS unsigned* MISC;
    gu32* ctl;
    unsigned char* ws;
    int tid, lane, wave, vcu, G;
    const float *x, *c, *ada_w, *ada_b, *mix_g, *w_in, *w_a, *w_r, *w_o, *rec_g, *lbl, *ffn_g, *rg_w, *rg_b, *re_w, *re_b, *e_gate, *e_up, *e_down, *fin_g;
    const int* pos;
    float* out;
    float *modp, *modf, *lb, *rwt, *tokw; int* list; int* cntw;
    bf16 *win_t, *wa_t, *wr_t, *wo_t, *w1_t, *w2_t, *U, *hdn, *row;
};

template <bool NT> __device__ __forceinline__ void tr_load(const float* W, int N, int lane, f32x4 (&v)[8]) {
#pragma unroll
    for (int i = 0; i < 8; ++i) { const GAS f32x4* p = (const GAS f32x4*)(W + (size_t)(8 * i + (lane >> 3)) * N + 4 * (lane & 7)); v[i] = NT ? __builtin_nontemporal_load(p) : *p; }
}
template <bool NT> __device__ __forceinline__ void tr_finish(const f32x4 (&v)[8], bf16* dst, int dK, LAS float* scr, int lane) {
#pragma unroll
    for (int i = 0; i < 8; ++i) { LAS float* q = scr + (8 * i + (lane >> 3)) * 33 + 4 * (lane & 7); q[0] = v[i].x; q[1] = v[i].y; q[2] = v[i].z; q[3] = v[i].w; }
    LDS_WAIT(); asm volatile("" ::: "memory");
    const int c = lane & 7;
#pragma unroll
    for (int j = 0; j < 4; ++j) { const int n = (lane >> 3) + 8 * j; const LAS float* s = scr + (8 * c) * 33 + n;
        v4u o; o.x = cvt_pk_bf16s(s[0 * 33], s[1 * 33]); o.y = cvt_pk_bf16s(s[2 * 33], s[3 * 33]); o.z = cvt_pk_bf16s(s[4 * 33], s[5 * 33]); o.w = cvt_pk_bf16s(s[6 * 33], s[7 * 33]);
        GAS v4u* d = (GAS v4u*)(dst + (size_t)n * dK + 8 * c); if (NT) __builtin_nontemporal_store(o, d); else *d = o; }
    LDS_WAIT(); asm volatile("" ::: "memory");
}
__device__ __forceinline__ unsigned pk4_fp8(float a, float b, float c, float d) { unsigned r = 0u; r = (unsigned)__builtin_amdgcn_cvt_pk_fp8_f32(a, b, (int)r, false); r = (unsigned)__builtin_amdgcn_cvt_pk_fp8_f32(c, d, (int)r, true); return r; }
template <bool NT> __device__ __forceinline__ void tr_finish8(const f32x4 (&v)[8], unsigned char* dst, int dKb, LAS float* scr, int lane) {
#pragma unroll
    for (int i = 0; i < 8; ++i) { LAS float* q = scr + (8 * i + (lane >> 3)) * 33 + 4 * (lane & 7); q[0] = v[i].x * 32.f; q[1] = v[i].y * 32.f; q[2] = v[i].z * 32.f; q[3] = v[i].w * 32.f; }
    LDS_WAIT(); asm volatile("" ::: "memory");
    const int c = lane & 7;
#pragma unroll
    for (int j = 0; j < 4; ++j) { const int n = (lane >> 3) + 8 * j; const LAS float* s = scr + (8 * c) * 33 + n;
        v2u o; o.x = pk4_fp8(s[0 * 33], s[1 * 33], s[2 * 33], s[3 * 33]); o.y = pk4_fp8(s[4 * 33], s[5 * 33], s[6 * 33], s[7 * 33]);
        GAS v2u* d = (GAS v2u*)(dst + (size_t)n * dKb + 8 * c); if (NT) __builtin_nontemporal_store(o, d); else *d = o; }
    LDS_WAIT(); asm volatile("" ::: "memory");
}
template <bool NT = false> __device__ __forceinline__ void tr_item(const float* W, int N, bf16* dst, int dK, LAS float* scr, int lane) {
    f32x4 v[8]; tr_load<NT>(W, N, lane, v); tr_finish<NT>(v, dst, dK, scr, lane);
}
__device__ __forceinline__ void p0_item_addr(Frame& F, int r, const float*& src, int& N, bf16*& dst, int& dK) {
    constexpr int I_IN = 32 * 576, I_SQ = 32 * 64;
    if (r < I_IN) { const int kb = r / 576, nb = r % 576; src = F.w_in + (size_t)(64 * kb) * RB + 32 * nb; N = RB; dst = F.win_t + (size_t)(32 * nb) * D + 64 * kb; dK = D; return; }
    r -= I_IN; const int w = r / I_SQ, q = r % I_SQ, kb = q / 64, nb = q % 64; const size_t so = (size_t)(64 * kb) * D + 32 * nb, dof = (size_t)(32 * nb) * D + 64 * kb;
    N = D; dK = D;
    if (w == 0) { src = F.w_a + so; dst = F.wa_t + dof; } else if (w == 1) { src = F.w_r + so; dst = F.wr_t + dof; } else { src = F.w_o + so; dst = F.wo_t + dof; }
}
__device__ __forceinline__ void p0_phase(Frame& F) {
    {
        LAS float* sc = (LAS float*)(F.lds);
        for (int it = F.vcu; it < 192; it += F.G) {
            const int kc = it / 6, nc = it % 6;
            { const int b = F.tid >> 6, k = F.tid & 63; const float cv = F.c[b * D + kc * 64 + k]; sc[b * 64 + k] = siluf_(cv); }
            __syncthreads();
            const GAS float* w = (const GAS float*)F.ada_w + (size_t)(kc * 64) * 12288 + nc * 2048 + F.tid * 4;
            f32x4 acc[8];
#pragma unroll
            for (int b = 0; b < 8; ++b) acc[b] = (f32x4){0.f, 0.f, 0.f, 0.f};
#pragma unroll 8
            for (int k = 0; k < 64; ++k) { const f32x4 wv = *(const GAS f32x4*)(w + (size_t)k * 12288);
#pragma unroll
                for (int b = 0; b < 8; ++b) acc[b] += sc[b * 64 + k] * wv; }
#pragma unroll
            for (int b = 0; b < 8; ++b) *(GAS f32x4*)(F.modp + (size_t)(kc * 8 + b) * 12288 + nc * 2048 + F.tid * 4) = acc[b];
            __syncthreads();
        }
    }
    LAS float* scr = (LAS float*)(F.lds + F.wave * 16384);
    const int gw = F.vcu * 8 + F.wave, NGW = F.G * 8;
    constexpr int I_IN = 32 * 576, I_SQ = 32 * 64, NITEMS = I_IN + 3 * I_SQ;
    constexpr int NF8 = ((F8_SQ >> 0) & 1) + ((F8_SQ >> 1) & 1) + ((F8_SQ >> 2) & 1), NB16 = NITEMS - NF8 * I_SQ;
    static_assert(F8_SQ == 0 || F8_SQ == 4 || F8_SQ == 6 || F8_SQ == 7, "fp8 square weights must be a suffix");
    for (int it = gw; it < NB16; it += 2 * NGW) {
        const float* s0; int N0; bf16* d0; int K0; const float* s1 = nullptr; int N1 = 0; bf16* d1 = nullptr; int K1 = 0; f32x4 va[8], vb[8];
        p0_item_addr(F, it, s0, N0, d0, K0); tr_load<false>(s0, N0, F.lane, va);
        const bool two = it + NGW < NB16;
        if (two) { p0_item_addr(F, it + NGW, s1, N1, d1, K1); tr_load<false>(s1, N1, F.lane, vb); }
        tr_finish<false>(va, d0, K0, scr, F.lane);
        if (two) tr_finish<false>(vb, d1, K1, scr, F.lane);
    }
    for (int it = NB16 + gw; it < NITEMS; it += 2 * NGW) {
        const float* s0; int N0; bf16* d0; int K0; const float* s1 = nullptr; int N1 = 0; bf16* d1 = nullptr; int K1 = 0; f32x4 va[8], vb[8];
        p0_item_addr(F, it, s0, N0, d0, K0); tr_load<false>(s0, N0, F.lane, va);
        const bool two = it + NGW < NITEMS;
        if (two) { p0_item_addr(F, it + NGW, s1, N1, d1, K1); tr_load<false>(s1, N1, F.lane, vb); }
        { const int q = (it - I_IN) % I_SQ; tr_finish8<false>(va, (unsigned char*)d0 - ((size_t)(32 * (q % 64)) * D + 64 * (q / 64)), K0, scr, F.lane); }
        if (two) { const int q = (it + NGW - I_IN) % I_SQ; tr_finish8<false>(vb, (unsigned char*)d1 - ((size_t)(32 * (q % 64)) * D + 64 * (q / 64)), K1, scr, F.lane); }
    }
}
__device__ __forceinline__ void expert_item_addr(Frame& F, int r, const float*& src, int& N, unsigned char*& dst, int& dK) {
    constexpr int I_EX = 32 * 1024;
    if (r < 2 * I_EX) { const int up = r >= I_EX ? 1 : 0, q = r - up * I_EX, e = q / 1024, q2 = q % 1024, kb = q2 / 32, nb = q2 % 32, n0 = 32 * nb, np = (n0 >> 7) * 256 + up * 128 + (n0 & 127);
        const size_t so = (size_t)e * D * EH + (size_t)(64 * kb) * EH + n0; src = up ? F.e_up + so : F.e_gate + so; N = EH; dst = (unsigned char*)F.w1_t + (size_t)e * D * D + (size_t)np * D + 64 * kb; dK = D; }
    else { const int q = r - 2 * I_EX, e = q / 1024, q2 = q % 1024, kb = q2 / 64, nb = q2 % 64;
        src = F.e_down + (size_t)e * EH * D + (size_t)(64 * kb) * D + 32 * nb; N = D; dst = (unsigned char*)F.w2_t + (size_t)e * D * EH + (size_t)(32 * nb) * EH + 64 * kb; dK = EH; }
}

__device__ __forceinline__ float inv_freq_rev(int i) {
    constexpr float t[16] = {0.15915494309189535f, 0.0700865215877985f, 0.03086376340470123f, 0.013591370636193905f, 0.005985185712713705f, 0.002635675898667414f, 0.001160663641240061f, 0.0005111175045375439f,
                             0.00022507907903927653f, 9.911730936901935e-05f, 4.364795279280289e-05f, 1.9221100684944863e-05f, 8.464330808241401e-06f, 3.727408601915352e-06f, 1.6414262627950345e-06f, 7.228293068832865e-07f};
    return t[i];
}
__device__ __forceinline__ void p1_phase(Frame& F) {
    const int gt = F.vcu * 512 + F.tid, GT = F.G * 512;
    for (int i = gt; i < 2048; i += GT) { const float l0 = F.lbl[i], l1 = F.lbl[2048 + i]; F.lb[i] = 1.f / (1.f + __expf(l1 - l0)); }
    for (int i = gt; i < 48 * 2048; i += GT) { const int n = i / 2048, k = i % 2048; const float wv = n < 32 ? F.re_w[k * 32 + n] : (n < 36 ? F.rg_w[k * 4 + (n - 32)] : 0.f);
        const unsigned hb = f2bf(wv); const float hv = __builtin_bit_cast(float, hb << 16); ((bf16*)F.rwt)[i] = (bf16)hb; ((bf16*)F.rwt)[48 * 2048 + i] = (bf16)f2bf(wv - hv); }
    for (int i = gt; i < 8 * 12288; i += GT) { const int b = i / 12288, n = i % 12288; float s = F.ada_b[n]; float pp[32];
#pragma unroll
        for (int kc = 0; kc < 32; ++kc) pp[kc] = ((const GAS float*)F.modp)[(size_t)(kc * 8 + b) * 12288 + n];
#pragma unroll
        for (int kc = 0; kc < 32; ++kc) s += pp[kc];
        F.modf[i] = s; }
    { const int gw = F.vcu * 8 + F.wave, NGW = F.G * 8; unsigned char* w8 = F.ws + WS_WIN8; float* wsc = (float*)(F.ws + WS_WSC);
      for (int n0 = gw; n0 < RB; n0 += 5 * NGW) {
          v4u wq[5][4];
#pragma unroll
          for (int i = 0; i < 5; ++i) { const int n = n0 + i * NGW; if (n < RB) {
#pragma unroll
              for (int j = 0; j < 4; ++j) wq[i][j] = *(const GAS v4u*)(F.win_t + (size_t)n * D + 8 * (F.lane + 64 * j)); } }
#pragma unroll
          for (int i = 0; i < 5; ++i) { const int n = n0 + i * NGW; if (n < RB) {
              float m = 0.f;
#pragma unroll
              for (int j = 0; j < 4; ++j) { const v4u q = wq[i][j];
                  m = fmaxf(fmaxf(fmaxf(m, fabsf(bflo(q.x))), fmaxf(fabsf(bfhi(q.x)), fabsf(bflo(q.y)))), fmaxf(fmaxf(fabsf(bfhi(q.y)), fabsf(bflo(q.z))), fmaxf(fabsf(bfhi(q.z)), fmaxf(fabsf(bflo(q.w)), fabsf(bfhi(q.w)))))); }
              m = wave_max(m); const float inv = m > 0.f ? 127.f / m : 0.f;
              if (F.lane == 0) wsc[n] = m * (1.f / 127.f);
#pragma unroll
              for (int j = 0; j < 4; ++j) { const v4u q = wq[i][j]; v2u o; o.x = pack4_i8(bflo(q.x) * inv, bfhi(q.x) * inv, bflo(q.y) * inv, bfhi(q.y) * inv); o.y = pack4_i8(bflo(q.z) * inv, bfhi(q.z) * inv, bflo(q.w) * inv, bfhi(q.w) * inv);
                  *(GAS v2u*)(w8 + (size_t)n * D + 8 * (F.lane + 64 * j)) = o; } } }
      } }
    LAS float* sh = (LAS float*)F.lds; LAS float* sg = sh + 2048;
    for (int rb = F.vcu; rb < 256; rb += F.G) {
        const int b = rb >> 5;
#pragma unroll 2
        for (int k = F.tid; k < 2048; k += 512) { float s0 = F.ada_b[k], s1 = F.ada_b[2048 + k]; float pa[32], pb[32];
#pragma unroll
            for (int kc = 0; kc < 32; ++kc) { const GAS float* p = (const GAS float*)F.modp + (size_t)(kc * 8 + b) * 12288; pa[kc] = p[k]; pb[kc] = p[2048 + k]; }
#pragma unroll
            for (int kc = 0; kc < 32; ++kc) { s0 += pa[kc]; s1 += pb[kc]; }
            sh[k] = s0; sg[k] = (1.f + s1) * F.mix_g[k]; }
        __syncthreads();
        for (int r4 = 0; r4 < 8; r4 += 2) {
            f32x4 v[2][8]; float ss[2];
#pragma unroll
            for (int r = 0; r < 2; ++r) { const GAS f32x4* xr = (const GAS f32x4*)(F.x + (size_t)(rb * 64 + F.wave * 8 + r4 + r) * D) + F.lane;
#pragma unroll
                for (int j = 0; j < 8; ++j) v[r][j] = xr[64 * j]; }
#pragma unroll
            for (int r = 0; r < 2; ++r) { float s = 0.f;
#pragma unroll
                for (int j = 0; j < 8; ++j) s += (v[r][j].x * v[r][j].x + v[r][j].y * v[r][j].y) + (v[r][j].z * v[r][j].z + v[r][j].w * v[r][j].w);
                ss[r] = s; }
#pragma unroll
            for (int o = 1; o < 64; o <<= 1) { ss[0] += __shfl_xor(ss[0], o); ss[1] += __shfl_xor(ss[1], o); }
            float mx[2];
#pragma unroll
            for (int r = 0; r < 2; ++r) { const float rstd = rsqrtf(ss[r] * (1.f / D) + 1e-6f); float m = 0.f;
#pragma unroll
                for (int j = 0; j < 8; ++j) { const f32x4 g4 = *(const LAS f32x4*)(sg + 4 * (F.lane + 64 * j)), h4 = *(const LAS f32x4*)(sh + 4 * (F.lane + 64 * j));
                    const f32x4 y = v[r][j] * rstd * g4 + h4; v[r][j] = y; m = fmaxf(fmaxf(m, fmaxf(fabsf(y.x), fabsf(y.y))), fmaxf(fabsf(y.z), fabsf(y.w))); }
                mx[r] = m; }
#pragma unroll
            for (int o = 1; o < 64; o <<= 1) { mx[0] = fmaxf(mx[0], __shfl_xor(mx[0], o)); mx[1] = fmaxf(mx[1], __shfl_xor(mx[1], o)); }
#pragma unroll
            for (int r = 0; r < 2; ++r) { const int row = rb * 64 + F.wave * 8 + r4 + r; const float inv = mx[r] > 0.f ? 127.f / mx[r] : 0.f;
                if (F.lane == 0) ((float*)(F.ws + WS_USC))[row] = mx[r] * (1.f / 127.f);
                GAS unsigned* o8 = (GAS unsigned*)((unsigned char*)F.U + (size_t)row * D) + F.lane;
#pragma unroll
                for (int j = 0; j < 8; ++j) { const f32x4 y = v[r][j] * inv; o8[64 * j] = pack4_i8(y.x, y.y, y.z, y.w); } }
        }
        __syncthreads();
    }
}

__device__ __forceinline__ constexpr float cut11(float c) { return __builtin_bit_cast(float, __builtin_bit_cast(unsigned, c) & 0xffffe000u); }
typedef int i32x4q __attribute__((ext_vector_type(4)));
struct EpiProj {
    static constexpr bool PERM = true; static constexpr bool HAS_PRE = true;
    bf16* O; const int* pos; bf16* KV; const float* usc; const float* wsc; LAS float* sc;
    typedef float f32x2 __attribute__((ext_vector_type(2)));
    __device__ __forceinline__ f32x2 pre(const pg8::Unit& u) const { const int t = threadIdx.x; f32x2 r; r.x = t < 256 ? ((const GAS float*)usc)[u.pm * 256 + t] : ((const GAS float*)wsc)[u.pn * 256 + t - 256];
        const int pi = ((const GAS int*)pos)[u.pm * 256 + (t & 255)]; r.y = __builtin_bit_cast(float, pi); return r; }
    __device__ __forceinline__ void operator()(const f32x4 (&acc)[2][2][4][2], const pg8::Unit& u, int wr, int wc, int fr, int fq, f32x2 prev) const {
        const int sec = u.pn >> 3;
        const int row0 = u.pm * 256 + wr * 64 + fr, col0 = u.pn * 256 + wc * 32 + 8 * fq;
        const bool rot = (sec < 2) && (wc == 0);
        const float qs = (sec == 0) ? 0.12751743082459868f : 1.f;
        float pf[2][4], rs[2][4]; f32x4 cs[2][2];
#pragma unroll
        for (int ai = 0; ai < 2; ++ai)
#pragma unroll
            for (int m = 0; m < 4; ++m) pf[ai][m] = 0.f;
        sc[threadIdx.x] = prev.x; if (threadIdx.x < 256) { const float py = prev.y; sc[512 + threadIdx.x] = (float)__builtin_bit_cast(int, py); }
        asm volatile("s_waitcnt lgkmcnt(0)" ::: "memory"); __builtin_amdgcn_s_barrier(); asm volatile("" ::: "memory");
#pragma unroll
        for (int ai = 0; ai < 2; ++ai)
#pragma unroll
            for (int m = 0; m < 4; ++m) { rs[ai][m] = sc[wr * 64 + fr + ai * 128 + m * 16]; if (rot) pf[ai][m] = sc[512 + wr * 64 + fr + ai * 128 + m * 16]; }
#pragma unroll
        for (int bj = 0; bj < 2; ++bj)
#pragma unroll
            for (int n = 0; n < 2; ++n) cs[bj][n] = *(const LAS f32x4*)(sc + 256 + wc * 32 + 8 * fq + bj * 128 + 4 * n);
#pragma unroll
        for (int ai = 0; ai < 2; ++ai)
#pragma unroll
            for (int m = 0; m < 4; ++m) {
                const int row = row0 + ai * 128 + m * 16;
#pragma unroll
                for (int bj = 0; bj < 2; ++bj) {
                    float v[8];
                    const i32x4q c0 = __builtin_bit_cast(i32x4q, acc[ai][bj][m][0]), c1 = __builtin_bit_cast(i32x4q, acc[ai][bj][m][1]);
#pragma unroll
                    for (int j = 0; j < 4; ++j) { v[j] = (float)c0[j] * rs[ai][m] * cs[bj][0][j]; v[4 + j] = (float)c1[j] * rs[ai][m] * cs[bj][1][j]; }
                    if (rot) {
#pragma unroll
                        for (int j = 0; j < 8; ++j) {
                            const float ch = (fq & 1) ? cut11(inv_freq_rev(8 + j)) : cut11(inv_freq_rev(j)), cl = (fq & 1) ? (inv_freq_rev(8 + j) - cut11(inv_freq_rev(8 + j))) : (inv_freq_rev(j) - cut11(inv_freq_rev(j)));
                            const float p0 = pf[ai][m] * ch; const float fr_ = (p0 - __builtin_floorf(p0)) + pf[ai][m] * cl;
                            const float sn = __builtin_amdgcn_sinf(fr_), cs = __builtin_amdgcn_cosf(fr_);
                            const float other = __shfl_xor(v[j], 32);
                            v[j] = v[j] * cs + ((fq < 2) ? -other : other) * sn;
                        }
                    }
                    if (sec == 0) {
#pragma unroll
                        for (int j = 0; j < 8; ++j) v[j] *= qs;
                    } else if (sec == 3 || sec == 6) {
#pragma unroll
                        for (int j = 0; j < 8; ++j) v[j] = siluf_(v[j]);
                    } else if (sec >= 7) {
#pragma unroll
                        for (int j = 0; j < 8; ++j) v[j] = sigmoidf_(v[j]);
                    }
                    v4u w; w.x = cvt_pk_bf16s(v[0], v[1]); w.y = cvt_pk_bf16s(v[2], v[3]); w.z = cvt_pk_bf16s(v[4], v[5]); w.w = cvt_pk_bf16s(v[6], v[7]);
                    if (sec == 1 || sec == 2) {
                        const int hd = (u.pn & 7) * 2 + bj;
                        *(GAS v4u*)(KV + (size_t)(sec - 1) * (KV_VOFF / 2) + ((size_t)((row >> 11) * NHEAD + hd) * SEQ + (row & (SEQ - 1))) * HD + wc * 32 + 8 * fq) = w;
                    } else *(GAS v4u*)(O + (size_t)row * RB + col0 + bj * 128) = w;
                }
            }
    }
};
template <int SECOND> struct EpiGate {
    static constexpr bool PERM = true; static constexpr bool HAS_PRE = false;
    bf16* R;
    __device__ __forceinline__ void operator()(const f32x4 (&acc)[2][2][4][2], const pg8::Unit& u, int wr, int wc, int fr, int fq) const {
        const int row0 = u.pm * 256 + wr * 64 + fr, col0 = u.pn * 256 + wc * 32 + 8 * fq;
        constexpr float WS_ = ((F8_SQ >> SECOND) & 1) ? WSI : 1.f;
#pragma unroll
        for (int ai = 0; ai < 2; ++ai) {
            v4u g[4][2], t[4][2];
#pragma unroll
            for (int m = 0; m < 4; ++m)
#pragma unroll
                for (int bj = 0; bj < 2; ++bj) { const bf16* rp = R + (size_t)(row0 + ai * 128 + m * 16) * RB + col0 + bj * 128; g[m][bj] = *(const GAS v4u*)(rp + (SECOND ? S_GB : S_GA)); if (SECOND) t[m][bj] = *(const GAS v4u*)(rp + S_MG); }
#pragma unroll
            for (int m = 0; m < 4; ++m)
#pragma unroll
                for (int bj = 0; bj < 2; ++bj) {
                    bf16* rp = R + (size_t)(row0 + ai * 128 + m * 16) * RB + col0 + bj * 128;
                    float v[8]; const v4u gg = g[m][bj];
#pragma unroll
                    for (int j = 0; j < 4; ++j) { v[j] = acc[ai][bj][m][0][j] * WS_; v[4 + j] = acc[ai][bj][m][1][j] * WS_; }
                    v[0] *= bflo(gg.x); v[1] *= bfhi(gg.x); v[2] *= bflo(gg.y); v[3] *= bfhi(gg.y); v[4] *= bflo(gg.z); v[5] *= bfhi(gg.z); v[6] *= bflo(gg.w); v[7] *= bfhi(gg.w);
                    if (SECOND) { const v4u tt = t[m][bj];
                        v[0] += bflo(tt.x); v[1] += bfhi(tt.x); v[2] += bflo(tt.y); v[3] += bfhi(tt.y); v[4] += bflo(tt.z); v[5] += bfhi(tt.z); v[6] += bflo(tt.w); v[7] += bfhi(tt.w); }
                    if (SECOND && (F8_SQ & 4)) {
                        v2u w8; w8.x = pk4_fp8(v[0], v[1], v[2], v[3]); w8.y = pk4_fp8(v[4], v[5], v[6], v[7]);
                        *(GAS v2u*)((unsigned char*)(R + (size_t)(row0 + ai * 128 + m * 16) * RB + S_VA) + col0 + bj * 128) = w8;
                    } else {
                    v4u w; w.x = cvt_pk_bf16s(v[0], v[1]); w.y = cvt_pk_bf16s(v[2], v[3]); w.z = cvt_pk_bf16s(v[4], v[5]); w.w = cvt_pk_bf16s(v[6], v[7]);
                    *(GAS v4u*)(rp + S_MG) = w; }
                }
        }
    }
};
struct EpiH {
    static constexpr bool PERM = true; static constexpr bool HAS_PRE = false;
    const float* modf; const float* x; float* H; float* psum; LAS float* ps;
    __device__ __forceinline__ void operator()(const f32x4 (&acc)[2][2][4][2], const pg8::Unit& u, int wr, int wc, int fr, int fq) const {
        const int row0 = u.pm * 256 + wr * 64 + fr, col0 = u.pn * 256 + wc * 32 + 8 * fq;
        const GAS float* gt = (const GAS float*)modf + (size_t)(u.pm >> 3) * 12288 + 2 * D;
        f32x4 gv[2][2];
#pragma unroll
        for (int bj = 0; bj < 2; ++bj)
#pragma unroll
            for (int n = 0; n < 2; ++n) gv[bj][n] = *(const GAS f32x4*)(gt + col0 + bj * 128 + 4 * n) * ((F8_SQ & 4) ? WSI : 1.f);
#pragma unroll
        for (int ai = 0; ai < 2; ++ai) {
            f32x4 xv[4][2][2];
#pragma unroll
            for (int m = 0; m < 4; ++m)
#pragma unroll
                for (int bj = 0; bj < 2; ++bj)
#pragma unroll
                    for (int n = 0; n < 2; ++n) xv[m][bj][n] = *(const GAS f32x4*)((const GAS float*)x + (size_t)(row0 + ai * 128 + m * 16) * D + col0 + bj * 128 + 4 * n);
            __builtin_amdgcn_sched_barrier(0);
#pragma unroll
            for (int m = 0; m < 4; ++m) { const size_t ro = (size_t)(row0 + ai * 128 + m * 16) * D + col0; float sq = 0.f;
#pragma unroll
                for (int bj = 0; bj < 2; ++bj) { GAS float* hp = (GAS float*)H + ro + bj * 128;
                    const f32x4 h0 = xv[m][bj][0] + gv[bj][0] * acc[ai][bj][m][0], h1 = xv[m][bj][1] + gv[bj][1] * acc[ai][bj][m][1];
                    *(GAS f32x4*)hp = h0; *(GAS f32x4*)(hp + 4) = h1;
                    sq += ((h0[0] * h0[0] + h0[1] * h0[1]) + (h0[2] * h0[2] + h0[3] * h0[3])) + ((h1[0] * h1[0] + h1[1] * h1[1]) + (h1[2] * h1[2] + h1[3] * h1[3])); }
                sq += __shfl_xor(sq, 16); sq += __shfl_xor(sq, 32);
                if (fq == 0) ps[(ai * 128 + wr * 64 + m * 16 + fr) * 4 + wc] = sq; }
        }
        asm volatile("s_waitcnt lgkmcnt(0)" ::: "memory"); __builtin_amdgcn_s_barrier(); asm volatile("" ::: "memory");
        if (threadIdx.x < 256) { const f32x4 p = *(const LAS f32x4*)(ps + threadIdx.x * 4); ((GAS float*)psum)[(size_t)u.pn * T + u.pm * 256 + threadIdx.x] = (p[0] + p[1]) + (p[2] + p[3]); }
    }
};
struct EpiSwiGLU {
    static constexpr bool PERM = true; static constexpr bool HAS_PRE = false;
    bf16* H;
    __device__ __forceinline__ void operator()(const f32x4 (&acc)[2][2][4][2], const pg8::Unit& u, int wr, int wc, int fr, int fq) const {
        const int row0 = u.pm * 256 + wr * 64 + fr, col0 = u.pn * 128 + wc * 32 + 8 * fq;
#pragma unroll
        for (int ai = 0; ai < 2; ++ai)
#pragma unroll
            for (int m = 0; m < 4; ++m) { float v[8];
#pragma unroll
                for (int j = 0; j < 4; ++j) { v[j] = siluf_(acc[ai][0][m][0][j] * WSI) * (acc[ai][1][m][0][j] * WSI); v[4 + j] = siluf_(acc[ai][0][m][1][j] * WSI) * (acc[ai][1][m][1][j] * WSI); }
                v2u w; w.x = pk4_fp8(v[0], v[1], v[2], v[3]); w.y = pk4_fp8(v[4], v[5], v[6], v[7]);
                *(GAS v2u*)((unsigned char*)H + (size_t)(row0 + ai * 128 + m * 16) * EH + col0) = w; }
    }
};
struct EpiScatter {
    static constexpr bool PERM = true; static constexpr bool HAS_PRE = false;
    bf16* R; const int* list; const LAS unsigned short* pre; const LAS int* rowtab;
    __device__ __forceinline__ void operator()(const f32x4 (&acc)[2][2][4][2], const pg8::Unit& u, int wr, int wc, int fr, int fq) const {
        const int col0 = u.pn * 256 + wc * 32 + 8 * fq;
        int en[2][4];
#pragma unroll
        for (int ai = 0; ai < 2; ++ai)
#pragma unroll
            for (int m = 0; m < 4; ++m) { const int r = ai * 128 + wr * 64 + m * 16 + fr; en[ai][m] = rowtab[u.par * 256 + r]; }
#pragma unroll
        for (int ai = 0; ai < 2; ++ai)
#pragma unroll
            for (int m = 0; m < 4; ++m) {
                if (en[ai][m] >= 0) { bf16* rp = R + (size_t)(en[ai][m] >> 1) * RB + ((en[ai][m] & 1) ? S_Y1 : S_Y0) + col0;
#pragma unroll
                    for (int bj = 0; bj < 2; ++bj) { const f32x4 a0 = acc[ai][bj][m][0] * WSI, a1 = acc[ai][bj][m][1] * WSI; v4u w; w.x = cvt_pk_bf16s(a0[0], a0[1]); w.y = cvt_pk_bf16s(a0[2], a0[3]);
                        w.z = cvt_pk_bf16s(a1[0], a1[1]); w.w = cvt_pk_bf16s(a1[2], a1[3]); *(GAS v4u*)(rp + bj * 128) = w; } } }
    }
};

__device__ __forceinline__ unsigned short f2bf16(float f) { return (unsigned short)f2bf(f); }
__device__ __forceinline__ void hgrn_unit2(Frame& F, int b, int h) {
    LAS unsigned char* L = F.lds;
    constexpr int PQ = 272, PL = 288, PP = 144, POF = 132;
    constexpr int QE_OFF = 0, KE_OFF = 64 * PQ, KL_OFF = 2 * 64 * PQ, V_OFF = KL_OFF + 64 * PL, P_OFF = V_OFF + 64 * PL, O_OFF = P_OFF + 64 * PP, DEC_OFF = O_OFF + 64 * POF * 4, QS_OFF = DEC_OFF + 512;
    constexpr int RF_OFF = QS_OFF + 2048, RQ_OFF = RF_OFF + 16384;
    static_assert(RQ_OFF + 16384 <= LDSCTL_OFF, "hgrn LDS map");
    const int tid = F.tid, lane = F.lane, w = F.wave, l15 = lane & 15, g = lane >> 4, q4 = l15 >> 2, p4 = l15 & 3;
    const int kcol = tid & 127, tq = tid >> 7;
    const float lbk = F.lb[h * 128 + kcol];
    f32x4 st[8];
#pragma unroll
    for (int kt = 0; kt < 8; ++kt) st[kt] = (f32x4){0.f, 0.f, 0.f, 0.f};
    LAS float* QS = (LAS float*)(L + QS_OFF); LAS float* DEC = (LAS float*)(L + DEC_OFF); LAS float* O = (LAS float*)(L + O_OFF);
    v4u pfF[2], pfQ[2], pfV[2], pfG[2];
    const bf16* ubase = F.row + (size_t)b * SEQ * RB + h * 128;
    const unsigned po0c = (unsigned)(tid >> 4) * (unsigned)(RB * 2) + (unsigned)((tid & 15) * 16), po1c = po0c + 32u * (unsigned)(RB * 2);
    const unsigned pogc = (unsigned)(tid >> 3) * (unsigned)(RB * 2) + (unsigned)((16 * (tid & 7) + S_GR) * 2);
#define HG_PF_BASE(ch_) const GAS char* cb_ = (const GAS char*)ubase + (size_t)((ch_) * 64) * (RB * 2); unsigned po0 = po0c, po1 = po1c, pog = pogc; asm volatile("" : "+v"(po0), "+v"(po1), "+v"(pog));
#define HG_PF_F(ch_) do { HG_PF_BASE(ch_) pfF[0] = *(const GAS v4u*)(cb_ + po0 + S_FR * 2); pfF[1] = *(const GAS v4u*)(cb_ + po1 + S_FR * 2); (void)pog; } while (0)
#define HG_PF_Q(ch_) do { HG_PF_BASE(ch_) pfQ[0] = *(const GAS v4u*)(cb_ + po0 + S_QR * 2); pfQ[1] = *(const GAS v4u*)(cb_ + po1 + S_QR * 2); (void)pog; } while (0)
#define HG_PF_V(ch_) do { HG_PF_BASE(ch_) pfV[0] = *(const GAS v4u*)(cb_ + po0 + S_IR * 2); pfV[1] = *(const GAS v4u*)(cb_ + po1 + S_IR * 2); (void)pog; } while (0)
#define HG_PF_G(ch_) do { HG_PF_BASE(ch_) pfG[0] = *(const GAS v4u*)(cb_ + pog); pfG[1] = *(const GAS v4u*)(cb_ + pog + 16); (void)po0; (void)po1; } while (0)
#define HG_PREFETCH(ch_) do { HG_PF_F(ch_); HG_PF_Q(ch_); HG_PF_V(ch_); HG_PF_G(ch_); } while (0)
#define HG_BAR() do { asm volatile("s_waitcnt lgkmcnt(0)" ::: "memory"); __builtin_amdgcn_s_barrier(); asm volatile("" ::: "memory"); } while (0)
    v4u pend0 = {0u, 0u, 0u, 0u}, pend1 = pend0; bf16* pendp = nullptr; unsigned char* pendq = nullptr;
    HG_PREFETCH(0);
    for (int ch = 0; ch < 32; ++ch) {
        const size_t row0 = (size_t)b * SEQ + ch * 64;
#pragma unroll
        for (int r = 0; r < 2; ++r) { const int idx = tid + 512 * r, s = idx >> 4, chn = idx & 15;
            *(LAS v4u*)(L + RF_OFF + s * 256 + chn * 16) = pfF[r]; *(LAS v4u*)(L + RQ_OFF + s * 256 + chn * 16) = pfQ[r]; *(LAS v4u*)(L + V_OFF + s * PL + chn * 16) = pfV[r]; }
        const v4u g0 = pfG[0], g1 = pfG[1];
        if (ch > 0) { if (F8_SQ & 2) *(GAS v4u*)pendq = pend0; else { *(GAS v4u*)(pendp + S_YR) = pend0; *(GAS v4u*)(pendp + S_YR + 8) = pend1; } }
        HG_BAR();
        if (ch < 31) HG_PF_F(ch + 1);
        float cb[16], kk[16], qv[16]; float run = 0.f;
#pragma unroll
        for (int i = 0; i < 16; ++i) { const float xf = __builtin_bit_cast(float, (unsigned)*(const LAS unsigned short*)(L + RF_OFF + (16 * tq + i) * 256 + kcol * 2) << 16);
            qv[i] = __builtin_bit_cast(float, (unsigned)*(const LAS unsigned short*)(L + RQ_OFF + (16 * tq + i) * 256 + kcol * 2) << 16);
            const float f = lbk + (1.f - lbk) * sigmoidf_(xf); run += __logf(f); cb[i] = run; kk[i] = 1.f - f; }
        QS[tq * 128 + kcol] = run;
        HG_BAR();
        if (ch < 31) HG_PF_Q(ch + 1);
        { float off = 0.f, tot = 0.f;
#pragma unroll
          for (int q = 0; q < 4; ++q) { const float z = QS[q * 128 + kcol]; off += (q < tq) ? z : 0.f; tot += z; }
#pragma unroll
          for (int i = 0; i < 16; ++i) { const float bb = off + cb[i], eb = __expf(bb);
              *(LAS unsigned short*)(L + QE_OFF + (16 * tq + i) * PQ + kcol * 2) = f2bf16(qv[i] * eb);
              *(LAS unsigned short*)(L + KE_OFF + (16 * tq + i) * PQ + kcol * 2) = f2bf16(kk[i] * __expf(-bb));
              *(LAS unsigned short*)(L + KL_OFF + (16 * tq + i) * PL + kcol * 2) = f2bf16(kk[i] * __expf(tot - bb)); }
          if (tq == 0) DEC[kcol] = __expf(tot); }
        HG_BAR();
        if (ch < 31) HG_PF_V(ch + 1);
        { const int tt = w >> 1;
#pragma unroll
          for (int si = 0; si < 2; ++si) { const int ss = 2 * (w & 1) + si; f32x4 acc = {0.f, 0.f, 0.f, 0.f};
              if (ss <= tt) {
#pragma unroll
                  for (int ks = 0; ks < 4; ++ks) { const bf16x8 a = *(const LAS bf16x8*)(L + QE_OFF + (16 * tt + l15) * PQ + ks * 64 + g * 16), bq = *(const LAS bf16x8*)(L + KE_OFF + (16 * ss + l15) * PQ + ks * 64 + g * 16);
                      acc = __builtin_amdgcn_mfma_f32_16x16x32_bf16(a, bq, acc, 0, 0, 0); } }
#pragma unroll
              for (int r = 0; r < 4; ++r) { const float val = (16 * ss + l15 <= 16 * tt + 4 * g + r) ? acc[r] : 0.f; *(LAS unsigned short*)(L + P_OFF + (16 * tt + 4 * g + r) * PP + (16 * ss + l15) * 2) = f2bf16(val); } } }
        HG_BAR();
        if (ch < 31) HG_PF_G(ch + 1);
        { bf16x8 vb[2];
#pragma unroll
          for (int ks = 0; ks < 2; ++ks) { const s16x4 lo = __builtin_amdgcn_ds_read_tr16_b64_v4i16((LAS s16x4*)(L + V_OFF + (32 * ks + 8 * g + q4) * PL + (16 * w + 4 * p4) * 2));
              const s16x4 hi = __builtin_amdgcn_ds_read_tr16_b64_v4i16((LAS s16x4*)(L + V_OFF + (32 * ks + 8 * g + 4 + q4) * PL + (16 * w + 4 * p4) * 2)); vb[ks] = __builtin_shufflevector(lo, hi, 0, 1, 2, 3, 4, 5, 6, 7); }
          f32x4 oacc[4];
#pragma unroll
          for (int tt = 0; tt < 4; ++tt) { oacc[tt] = (f32x4){0.f, 0.f, 0.f, 0.f};
#pragma unroll
              for (int ks = 0; ks < 2; ++ks) if (32 * ks <= 16 * tt + 15) { const bf16x8 a = *(const LAS bf16x8*)(L + P_OFF + (16 * tt + l15) * PP + ks * 64 + g * 16); oacc[tt] = __builtin_amdgcn_mfma_f32_16x16x32_bf16(a, vb[ks], oacc[tt], 0, 0, 0); } }
#pragma unroll
          for (int ks = 0; ks < 4; ++ks) { v4u pk; pk.x = cvt_pk_bf16(st[2 * ks][0], st[2 * ks][1]); pk.y = cvt_pk_bf16(st[2 * ks][2], st[2 * ks][3]); pk.z = cvt_pk_bf16(st[2 * ks + 1][0], st[2 * ks + 1][1]); pk.w = cvt_pk_bf16(st[2 * ks + 1][2], st[2 * ks + 1][3]);
              const bf16x8 sb = __builtin_bit_cast(bf16x8, pk);
#pragma unroll
              for (int tt = 0; tt < 4; ++tt) { const s16x4 alo = *(const LAS s16x4*)(L + QE_OFF + (16 * tt + l15) * PQ + (32 * ks + 4 * g) * 2), ahi = *(const LAS s16x4*)(L + QE_OFF + (16 * tt + l15) * PQ + (32 * ks + 16 + 4 * g) * 2);
                  const bf16x8 a = __builtin_shufflevector(alo, ahi, 0, 1, 2, 3, 4, 5, 6, 7); oacc[tt] = __builtin_amdgcn_mfma_f32_16x16x32_bf16(a, sb, oacc[tt], 0, 0, 0); } }
#pragma unroll
          for (int tt = 0; tt < 4; ++tt)
#pragma unroll
              for (int r = 0; r < 4; ++r) O[(16 * tt + 4 * g + r) * POF + 16 * w + l15] = oacc[tt][r];
#pragma unroll
          for (int kt = 0; kt < 8; ++kt) { const f32x4 d4 = *(const LAS f32x4*)(DEC + 16 * kt + 4 * g); st[kt] = st[kt] * d4;
#pragma unroll
              for (int ks = 0; ks < 2; ++ks) { const s16x4 lo = __builtin_amdgcn_ds_read_tr16_b64_v4i16((LAS s16x4*)(L + KL_OFF + (32 * ks + 8 * g + q4) * PL + (16 * kt + 4 * p4) * 2));
                  const s16x4 hi = __builtin_amdgcn_ds_read_tr16_b64_v4i16((LAS s16x4*)(L + KL_OFF + (32 * ks + 8 * g + 4 + q4) * PL + (16 * kt + 4 * p4) * 2));
                  const bf16x8 a = __builtin_shufflevector(lo, hi, 0, 1, 2, 3, 4, 5, 6, 7); st[kt] = __builtin_amdgcn_mfma_f32_16x16x32_bf16(a, vb[ks], st[kt], 0, 0, 0); } } }
        HG_BAR();

        { const int t = tid >> 3, vq = tid & 7; f32x4 o4[4]; float ss = 0.f;
#pragma unroll
          for (int j = 0; j < 4; ++j) { o4[j] = *(const LAS f32x4*)(O + t * POF + 16 * vq + 4 * j); ss += (o4[j].x * o4[j].x + o4[j].y * o4[j].y) + (o4[j].z * o4[j].z + o4[j].w * o4[j].w); }
          ss += __shfl_xor(ss, 1); ss += __shfl_xor(ss, 2); ss += __shfl_xor(ss, 4);
          const float rstd = rsqrtf(ss * (1.f / 128.f) + 1e-6f);
          bf16* rp = F.row + (row0 + t) * RB + h * 128 + 16 * vq;
          const GAS f32x4* ngp = (const GAS f32x4*)(F.rec_g + 16 * vq);
          const f32x4 n0 = ngp[0], n1 = ngp[1], n2 = ngp[2], n3 = ngp[3];
          v4u w0, w1;
          w0.x = pk2(o4[0].x * rstd * n0.x * bflo(g0.x), o4[0].y * rstd * n0.y * bfhi(g0.x)); w0.y = pk2(o4[0].z * rstd * n0.z * bflo(g0.y), o4[0].w * rstd * n0.w * bfhi(g0.y));
          w0.z = pk2(o4[1].x * rstd * n1.x * bflo(g0.z), o4[1].y * rstd * n1.y * bfhi(g0.z)); w0.w = pk2(o4[1].z * rstd * n1.z * bflo(g0.w), o4[1].w * rstd * n1.w * bfhi(g0.w));
          w1.x = pk2(o4[2].x * rstd * n2.x * bflo(g1.x), o4[2].y * rstd * n2.y * bfhi(g1.x)); w1.y = pk2(o4[2].z * rstd * n2.z * bflo(g1.y), o4[2].w * rstd * n2.w * bfhi(g1.y));
          w1.z = pk2(o4[3].x * rstd * n3.x * bflo(g1.z), o4[3].y * rstd * n3.y * bfhi(g1.z)); w1.w = pk2(o4[3].z * rstd * n3.z * bflo(g1.w), o4[3].w * rstd * n3.w * bfhi(g1.w));
          pend0 = w0; pend1 = w1; pendp = rp;
          if (F8_SQ & 2) {
              pend0.x = pk4_fp8(o4[0].x * rstd * n0.x * bflo(g0.x), o4[0].y * rstd * n0.y * bfhi(g0.x), o4[0].z * rstd * n0.z * bflo(g0.y), o4[0].w * rstd * n0.w * bfhi(g0.y));
              pend0.y = pk4_fp8(o4[1].x * rstd * n1.x * bflo(g0.z), o4[1].y * rstd * n1.y * bfhi(g0.z), o4[1].z * rstd * n1.z * bflo(g0.w), o4[1].w * rstd * n1.w * bfhi(g0.w));
              pend0.z = pk4_fp8(o4[2].x * rstd * n2.x * bflo(g1.x), o4[2].y * rstd * n2.y * bfhi(g1.x), o4[2].z * rstd * n2.z * bflo(g1.y), o4[2].w * rstd * n2.w * bfhi(g1.y));
              pend0.w = pk4_fp8(o4[3].x * rstd * n3.x * bflo(g1.z), o4[3].y * rstd * n3.y * bfhi(g1.z), o4[3].z * rstd * n3.z * bflo(g1.w), o4[3].w * rstd * n3.w * bfhi(g1.w));
              pendq = F.ws + WS_YR8 + (row0 + t) * (size_t)D + h * 128 + 16 * vq; } }
    }
    if (F8_SQ & 2) *(GAS v4u*)pendq = pend0; else { *(GAS v4u*)(pendp + S_YR) = pend0; *(GAS v4u*)(pendp + S_YR + 8) = pend1; }
#undef HG_PREFETCH
#undef HG_PF_BASE
#undef HG_PF_F
#undef HG_PF_Q
#undef HG_PF_V
#undef HG_PF_G
#undef HG_BAR
    __syncthreads();
}

__device__ __forceinline__ int crow(int r, int hi) { return (r & 3) + 8 * (r >> 2) + 4 * hi; }
__device__ __forceinline__ void glds16(const void* gsrc, unsigned lds_dst) { unsigned keep;
    asm volatile("s_mov_b32 %0, m0\n\ts_mov_b32 m0, %2\n\ts_nop 0\n\tglobal_load_lds_dwordx4 %1, off\n\ts_mov_b32 m0, %0" : "=&s"(keep) : "v"(gsrc), "s"(lds_dst) : "memory"); }
__device__ __forceinline__ int swzf(int row) { return ((row & 3) << 2) | ((row >> 2) & 3); }
__device__ __forceinline__ void vm_wait_n(int n) {
#define VMW(x) if (n >= x) { asm volatile("s_waitcnt vmcnt(" #x ")" ::: "memory"); return; }
    VMW(22) VMW(20) VMW(18) VMW(16) VMW(14) VMW(12) VMW(10) VMW(8) VMW(6) VMW(4) VMW(2)
#undef VMW
    asm volatile("s_waitcnt vmcnt(0)" ::: "memory");
}
template <int PIDX> __device__ __forceinline__ void attn_slide(Frame& F, bf16* base, const bf16* kvb, float* lsc, bf16* o2) {
    constexpr int R = (PIDX == 0) ? 1 : (PIDX == 1 ? 4 : 16), CL = (PIDX == 0) ? 64 : (PIDX == 1 ? 16 : 4), NT = 64, NS = 5;
    const int lane = F.lane, w = F.wave, qi = lane & 31, hh = lane >> 5;
    LAS unsigned char* ring = F.lds; const unsigned ringb = (unsigned)(size_t)ring;
    LAS unsigned char* qim = F.lds + NS * 16384 + w * 8192; const unsigned qimb = (unsigned)(size_t)qim;
    LAS unsigned char* xim = F.lds + NS * 16384 + 65536;
    const int G16 = lane >> 4, q4 = (lane & 15) >> 2, p4 = lane & 3;
    const int kg0 = hh ^ swzf(qi);
    int srow = 4 * w + (lane >> 4), sch = (lane & 15) ^ swzf(srow); asm volatile("" : "+v"(srow), "+v"(sch));
#define SL_STAGE(T_) do { const int tt_ = (T_); int sr_ = srow, sc_ = sch; asm volatile("" : "+v"(sr_), "+v"(sc_)); const unsigned off_ = (unsigned)((32 * (tt_ % CL) + sr_) * R + (tt_ / CL)) * 256u + (unsigned)(sc_ * 16); \
        const unsigned ld_ = (unsigned)__builtin_amdgcn_readfirstlane((int)(ringb + (unsigned)((tt_ % NS) * 16384 + w * 1024))); \
        glds16((const void*)((const char*)kvb + off_), ld_); glds16((const void*)((const char*)kvb + KV_VOFF + off_), ld_ + 8192u); } while (0)
#define SL_QLOAD(QT_) do { const int qq_ = (QT_); int l4_ = lane >> 4, l15_ = lane & 15; asm volatile("" : "+v"(l4_), "+v"(l15_)); _Pragma("unroll") for (int pc_ = 0; pc_ < 8; ++pc_) { const int rw_ = 4 * pc_ + l4_; const int ch_ = l15_ ^ swzf(rw_); \
        const unsigned off_ = (unsigned)((32 * (qq_ % CL) + rw_) * R + (qq_ / CL)) * (unsigned)(RB * 2) + (unsigned)((S_QA + ch_ * 8) * 2); \
        glds16((const void*)((const char*)base + off_), (unsigned)__builtin_amdgcn_readfirstlane((int)(qimb + (unsigned)(pc_ * 1024)))); } } while (0)
    SL_STAGE(0); SL_STAGE(1); SL_STAGE(2); SL_STAGE(3);
    int QT = w; SL_QLOAD(QT);
    asm volatile("s_waitcnt vmcnt(0)" ::: "memory");
    f32x16 o[4];
#pragma unroll
    for (int dt = 0; dt < 4; ++dt)
#pragma unroll
        for (int e = 0; e < 16; ++e) o[dt][e] = 0.f;
    float mrun = -1e30f, l = 0.f;
    int k = 100;
#define SL_FINAL() do { l += __shfl_xor(l, 32); const float inv_ = 1.f / l, lse_ = mrun + __builtin_amdgcn_logf(l); const int tq_ = (32 * (QT % CL) + qi) * R + (QT / CL); \
          \
        _Pragma("unroll") for (int dt = 0; dt < 4; ++dt) _Pragma("unroll") for (int g = 0; g < 4; ++g) { v2u pk; pk.x = cvt_pk_bf16(o[dt][4 * g] * inv_, o[dt][4 * g + 1] * inv_); pk.y = cvt_pk_bf16(o[dt][4 * g + 2] * inv_, o[dt][4 * g + 3] * inv_); \
            *(LAS v2u*)(xim + qi * 256 + (((4 * dt + g) ^ swzf(qi)) << 4) + 8 * hh) = pk; } \
        if (hh == 0) lsc[tq_] = lse_; \
        { int l4_ = lane >> 4, l15_ = lane & 15; asm volatile("" : "+v"(l4_), "+v"(l15_)); \
          _Pragma("unroll") for (int pc_ = 0; pc_ < 8; ++pc_) { if ((pc_ & 3) == 0) __builtin_amdgcn_sched_barrier(0); const int rw_ = 4 * pc_ + l4_; const int ch_ = l15_ ^ swzf(rw_); const v4u v_ = *(const LAS v4u*)(xim + rw_ * 256 + (l15_ << 4)); \
            const unsigned tr_ = (unsigned)((32 * (QT % CL) + rw_) * R + (QT / CL)); \
            if (PIDX == 2) *(GAS v4u*)((GAS char*)o2 + tr_ * 256u + (unsigned)(ch_ * 16)) = v_; \
            else *(GAS v4u*)((GAS char*)base + tr_ * (unsigned)(RB * 2) + (unsigned)(((PIDX == 0 ? S_KA : S_VA) + ch_ * 8) * 2)) = v_; } } \
        _Pragma("unroll") for (int dt = 0; dt < 4; ++dt) _Pragma("unroll") for (int e = 0; e < 16; ++e) o[dt][e] = 0.f; mrun = -1e30f; l = 0.f; } while (0)
    for (int T = 0; T < NT; ++T) {
        { const int rem = NT - 1 - T, dm = 2 * (rem < NS - 2 ? rem : NS - 2);
          const int ex = 8 + (QT < NT ? 8 : 0), late = rem - 1 < 0 ? 0 : (rem - 1 > 2 ? 2 : rem - 1);
          const int allowed = (k == 2 || k == 3) ? dm + ex : (k == 4 ? 8 + 2 * late : dm);
          vm_wait_n(allowed); }
        asm volatile("s_waitcnt lgkmcnt(0)" ::: "memory"); __builtin_amdgcn_s_barrier(); asm volatile("" ::: "memory");
        if (T + NS - 1 < NT) SL_STAGE(T + NS - 1);
        const int lo = (QT - 4) > CL * (QT / CL) ? (QT - 4) : CL * (QT / CL);
        if (QT < NT && T >= lo && T <= QT) {
            const int c = T - (QT - 4);
            const LAS unsigned char* kim = ring + (T % NS) * 16384; const LAS unsigned char* vim = kim + 8192;
            f32x16 s;
#pragma unroll
            for (int e = 0; e < 16; ++e) s[e] = 0.f;
#pragma unroll
            for (int kh = 0; kh < 4; ++kh) { bf16x8 kf[2], qq[2];
#pragma unroll
                for (int ks = 0; ks < 2; ++ks) { const int so = ((2 * (2 * kh + ks)) ^ kg0) << 4; kf[ks] = *(const LAS bf16x8*)(kim + qi * 256 + so); qq[ks] = *(const LAS bf16x8*)(qim + qi * 256 + so); }
                __builtin_amdgcn_sched_barrier(0);
#pragma unroll
                for (int ks = 0; ks < 2; ++ks) s = __builtin_amdgcn_mfma_f32_32x32x16_bf16(kf[ks], qq[ks], s, 0, 0, 0); }
            if (c == 0) {
#pragma unroll
                for (int e = 0; e < 16; ++e) if (crow(e, hh) < qi) s[e] = -1e30f;
            }
            if (c == 4) {
#pragma unroll
                for (int e = 0; e < 16; ++e) if (crow(e, hh) > qi) s[e] = -1e30f;
            }
            float mx = s[0];
#pragma unroll
            for (int e = 1; e < 16; ++e) mx = fmaxf(mx, s[e]);
            mx = fmaxf(mx, __shfl_xor(mx, 32));
            const bool grew = mx > mrun + 6.f; const float mn = grew ? mx : mrun, alpha = __builtin_amdgcn_exp2f(mrun - mn); mrun = mn;
            float ps = 0.f;
#pragma unroll
            for (int e = 0; e < 16; ++e) { s[e] = __builtin_amdgcn_exp2f(s[e] - mn); ps += s[e]; }
            l = l * alpha + ps;
            if (__any(grew)) {
#pragma unroll
                for (int dt = 0; dt < 4; ++dt)
#pragma unroll
                    for (int e = 0; e < 16; ++e) o[dt][e] *= alpha; }
            bf16x8 pb[2];
#pragma unroll
            for (int st = 0; st < 2; ++st) { v4u pk; pk.x = cvt_pk_bf16(s[8 * st + 0], s[8 * st + 1]); pk.y = cvt_pk_bf16(s[8 * st + 2], s[8 * st + 3]); pk.z = cvt_pk_bf16(s[8 * st + 4], s[8 * st + 5]); pk.w = cvt_pk_bf16(s[8 * st + 6], s[8 * st + 7]);
                pb[st] = __builtin_bit_cast(bf16x8, pk); }
#pragma unroll
            for (int dp = 0; dp < 2; ++dp) { s16x4 tv[2][2][2];
#pragma unroll
                for (int d2 = 0; d2 < 2; ++d2)
#pragma unroll
                    for (int st = 0; st < 2; ++st)
#pragma unroll
                        for (int e = 0; e < 2; ++e) { const int dt = 2 * dp + d2, row = 16 * st + 8 * e + 4 * hh + q4; const int chunk = 4 * dt + 2 * (G16 & 1) + (p4 >> 1);
                            tv[d2][st][e] = __builtin_amdgcn_ds_read_tr16_b64_v4i16((LAS s16x4*)(vim + row * 256 + ((chunk ^ swzf(row)) << 4) + (p4 & 1) * 8)); }
                __builtin_amdgcn_sched_barrier(0);
#pragma unroll
                for (int d2 = 0; d2 < 2; ++d2)
#pragma unroll
                    for (int st = 0; st < 2; ++st) { const bf16x8 va = __builtin_shufflevector(tv[d2][st][0], tv[d2][st][1], 0, 1, 2, 3, 4, 5, 6, 7);
                        o[2 * dp + d2] = __builtin_amdgcn_mfma_f32_32x32x16_bf16(va, pb[st], o[2 * dp + d2], 0, 0, 0); } }
            if (T == QT) k = 0;
        } else if (k == 1) { if (QT + 8 < NT) SL_QLOAD(QT + 8); SL_FINAL(); QT += 8; }
        ++k;
    }
    asm volatile("s_waitcnt lgkmcnt(0)" ::: "memory"); __builtin_amdgcn_s_barrier(); asm volatile("" ::: "memory");
    if (k == 1) { SL_FINAL(); }
    asm volatile("s_waitcnt vmcnt(0) lgkmcnt(0)" ::: "memory"); __builtin_amdgcn_s_barrier(); asm volatile("" ::: "memory");
#undef SL_STAGE
#undef SL_QLOAD
#undef SL_FINAL
}
__device__ __forceinline__ void attn_unit_bh(Frame& F, int b, int h, int slot) {
    const bf16* kvb = (const bf16*)F.out + (size_t)(b * NHEAD + h) * SEQ * HD;
    float* lsc = (float*)(F.ws + WS_U) + (size_t)slot * 8192;
    bf16* o2 = (bf16*)(F.ws + WS_U + 4 * MiB) + (size_t)slot * (2048 * 128);
    bf16* base = F.row + (size_t)b * SEQ * RB + h * 128;
    attn_slide<0>(F, base, kvb, lsc, o2);
    attn_slide<1>(F, base, kvb, lsc + 2048, o2);
    attn_slide<2>(F, base, kvb, lsc + 4096, o2);
    __syncthreads();
    int mt0 = F.tid; asm volatile("" : "+v"(mt0));
    float l0[2][4], l1[2][4], l2[2][4]; v4u x0[2][4], x1[2][4], x2[2][4];
#define ML_LOAD(S_, IT0_) do { _Pragma("unroll") for (int u = 0; u < 4; ++u) { const int it = (IT0_) + 512 * u, t = it >> 4, ch = it & 15; const bf16* rp = base + (size_t)t * RB + ch * 8; \
            l0[S_][u] = ((const GAS float*)lsc)[t]; l1[S_][u] = ((const GAS float*)lsc)[2048 + t]; l2[S_][u] = ((const GAS float*)lsc)[4096 + t]; \
            x0[S_][u] = *(const GAS v4u*)(rp + S_KA); x1[S_][u] = *(const GAS v4u*)(rp + S_VA); x2[S_][u] = *(const GAS v4u*)(o2 + (size_t)t * 128 + ch * 8); } } while (0)
#define ML_LO(p_) (a0 * bflo(x0[S][u].p_) + a1 * bflo(x1[S][u].p_) + a2 * bflo(x2[S][u].p_))
#define ML_HI(p_) (a0 * bfhi(x0[S][u].p_) + a1 * bfhi(x1[S][u].p_) + a2 * bfhi(x2[S][u].p_))
#define ML_MIX(p_) cvt_pk_bf16(a0 * bflo(x0[S][u].p_) + a1 * bflo(x1[S][u].p_) + a2 * bflo(x2[S][u].p_), a0 * bfhi(x0[S][u].p_) + a1 * bfhi(x1[S][u].p_) + a2 * bfhi(x2[S][u].p_))
    ML_LOAD(0, mt0);
#pragma unroll 1
    for (int it0 = mt0; it0 < 2048 * 16; it0 += 2 * 4 * 512) {
#pragma unroll
        for (int S = 0; S < 2; ++S) { const int itc = it0 + S * (4 * 512);
            if (itc + 4 * 512 < 2048 * 16) { if (S == 0) ML_LOAD(1, itc + 4 * 512); else ML_LOAD(0, itc + 4 * 512); }
#pragma unroll
            for (int u = 0; u < 4; ++u) { const int it = itc + 512 * u, t = it >> 4, ch = it & 15; bf16* rp = base + (size_t)t * RB + ch * 8;
                const float M = fmaxf(fmaxf(l0[S][u], l1[S][u]), l2[S][u]), w0 = __builtin_amdgcn_exp2f(l0[S][u] - M), w1 = __builtin_amdgcn_exp2f(l1[S][u] - M), w2 = __builtin_amdgcn_exp2f(l2[S][u] - M), dn = 1.f / (w0 + w1 + w2);
                const float a0 = w0 * dn, a1 = w1 * dn, a2 = w2 * dn;
                if (F8_SQ & 1) { v2u y8; y8.x = pk4_fp8(ML_LO(x), ML_HI(x), ML_LO(y), ML_HI(y)); y8.y = pk4_fp8(ML_LO(z), ML_HI(z), ML_LO(w), ML_HI(w));
                    *(GAS v2u*)(F.ws + WS_YA8 + ((size_t)b * SEQ + t) * D + h * 128 + ch * 8) = y8; (void)rp; }
                else { v4u y; y.x = ML_MIX(x); y.y = ML_MIX(y); y.z = ML_MIX(z); y.w = ML_MIX(w);
                *(GAS v4u*)(rp + S_YA) = y; } }
        }
    }
#undef ML_LOAD
#undef ML_MIX
#undef ML_LO
#undef ML_HI
    __syncthreads();
}
template <bool DEEP> __device__ __forceinline__ void convert_queue(Frame& F, int cw, int lo, int hi) {
    volatile LAS int* slot = (volatile LAS int*)(F.lds + TAB_OFF + 512);
    LAS float* scr = (LAS float*)(F.lds + F.wave * 16384);
    for (;;) {
        __syncthreads();
        if (F.tid == 0) slot[0] = lo + (int)__hip_atomic_fetch_add(F.ctl + cw, 1u, RLX_AGENT);
        __syncthreads();
        const int it = slot[0];
        if (it >= hi) break;
        if (!DEEP) { const float* src; int N; unsigned char* dst; int dK; f32x4 va[8], vb[8];
          expert_item_addr(F, it * 64 + F.wave * 8, src, N, dst, dK); tr_load<true>(src, N, F.lane, va);
#pragma unroll 1
          for (int j = 0; j < 8; j += 2) {
              const float* s1; int N1; unsigned char* d1; int dK1; expert_item_addr(F, it * 64 + F.wave * 8 + j + 1, s1, N1, d1, dK1); tr_load<true>(s1, N1, F.lane, vb);
              tr_finish8<true>(va, dst, dK, scr, F.lane);
              if (j + 2 < 8) { expert_item_addr(F, it * 64 + F.wave * 8 + j + 2, src, N, dst, dK); tr_load<true>(src, N, F.lane, va); }
              tr_finish8<true>(vb, d1, dK1, scr, F.lane);
          } }
        else {
          const int ib = it * 64 + F.wave * 8;
          const float* s0; const float* s1; const float* s2; const float* s3; int N0, N1, N2, N3, K0, K1, K2, K3; unsigned char* d0; unsigned char* d1; unsigned char* d2; unsigned char* d3; f32x4 va[8], vb[8], vc[8], vd[8];
          expert_item_addr(F, ib + 0, s0, N0, d0, K0); tr_load<true>(s0, N0, F.lane, va);
          expert_item_addr(F, ib + 1, s1, N1, d1, K1); tr_load<true>(s1, N1, F.lane, vb);
          expert_item_addr(F, ib + 2, s2, N2, d2, K2); tr_load<true>(s2, N2, F.lane, vc);
          expert_item_addr(F, ib + 3, s3, N3, d3, K3); tr_load<true>(s3, N3, F.lane, vd);
          tr_finish8<true>(va, d0, K0, scr, F.lane); expert_item_addr(F, ib + 4, s0, N0, d0, K0); tr_load<true>(s0, N0, F.lane, va);
          tr_finish8<true>(vb, d1, K1, scr, F.lane); expert_item_addr(F, ib + 5, s1, N1, d1, K1); tr_load<true>(s1, N1, F.lane, vb);
          tr_finish8<true>(vc, d2, K2, scr, F.lane); expert_item_addr(F, ib + 6, s2, N2, d2, K2); tr_load<true>(s2, N2, F.lane, vc);
          tr_finish8<true>(vd, d3, K3, scr, F.lane); expert_item_addr(F, ib + 7, s3, N3, d3, K3); tr_load<true>(s3, N3, F.lane, vd);
          tr_finish8<true>(va, d0, K0, scr, F.lane); tr_finish8<true>(vb, d1, K1, scr, F.lane); tr_finish8<true>(vc, d2, K2, scr, F.lane); tr_finish8<true>(vd, d3, K3, scr, F.lane); }
    }
    __syncthreads();
}
__device__ __forceinline__ void p3_phase(Frame& F) {
    volatile LAS int* slot = (volatile LAS int*)(F.lds + TAB_OFF);
    for (;;) {
        __syncthreads();
        if (F.tid == 0) slot[0] = (int)__hip_atomic_fetch_add(F.ctl + CW_QUEUE, 1u, RLX_AGENT);
        __syncthreads();
        const int it = slot[0];
        if (it >= 128) break;
        hgrn_unit2(F, it >> 4, it & 15);
    }
    for (;;) {
        __syncthreads();
        if (F.tid == 0) slot[0] = (int)__hip_atomic_fetch_add(F.ctl + CW_QUEUE + 64, 1u, RLX_AGENT);
        __syncthreads();
        const int it = slot[0];
        if (it >= 128) break;
        attn_unit_bh(F, it >> 4, it & 15, it);
    }
    convert_queue<false>(F, CW_QUEUE + 128, 0, 1024);
}

__device__ __forceinline__ void p6_phase(Frame& F) {
    LAS float* sh = (LAS float*)F.lds; LAS float* sg = sh + 2048; LAS float* SS = sg + 2048; LAS float* LG = SS + 128;
    LAS int* HI = (LAS int*)(LG + 8 * 16 * 48);
    const float* rowf = (const float*)F.row;
    const int lane = F.lane, w = F.wave, l15 = lane & 15, g = lane >> 4, rg = w >> 1, kh = w & 1;
    const bf16* rwh = (const bf16*)F.rwt; const bf16* rwl = rwh + 48 * 2048;
    for (int rb = F.vcu; rb < 256; rb += F.G) {
        const int b = rb >> 5;
        __syncthreads();
        for (int k = F.tid; k < 2048; k += 512) { sh[k] = F.modf[b * 12288 + 3 * D + k]; sg[k] = (1.f + F.modf[b * 12288 + 4 * D + k]) * F.ffn_g[k]; }
        if (F.tid < 32) HI[F.tid] = 0;
        __syncthreads();
        const int row = rb * 64 + rg * 16 + l15;
        float rstd; { const GAS float* pq = (const GAS float*)(F.ws + WS_PSUM) + row; float sq = 0.f;
#pragma unroll
            for (int n = 0; n < 8; ++n) sq += pq[(size_t)n * T];
            rstd = rsqrtf(sq * (1.f / D) + 1e-6f); }
        f32x4 acc[3];
#pragma unroll
        for (int nt = 0; nt < 3; ++nt) acc[nt] = (f32x4){0.f, 0.f, 0.f, 0.f};
        LAS unsigned char* WL = (LAS unsigned char*)(HI + 64);
        const GAS float* xr = (const GAS float*)F.out + (size_t)row * D + 8 * g;
        unsigned char* ur = (unsigned char*)(F.row + (size_t)row * RB + S_U2);
        f32x4 xa[2][4], xc[2][4];
#define P6_XLOAD(c_, s_) do { _Pragma("unroll") for (int kk = 0; kk < 4; ++kk) { const int ko = 256 * (c_) + 128 * kh + 32 * kk; xa[s_][kk] = *(const GAS f32x4*)(xr + ko); xc[s_][kk] = *(const GAS f32x4*)(xr + ko + 4); } } while (0)
#define P6_BAR() do { asm volatile("s_waitcnt lgkmcnt(0)" ::: "memory"); __builtin_amdgcn_s_barrier(); asm volatile("" ::: "memory"); } while (0)
        v4u wv[6];
#define P6_WLOAD(c_) do { _Pragma("unroll") for (int p = 0; p < 6; ++p) { const int idx = F.tid + 512 * p, hl = idx / 1536, rem = idx % 1536, n = rem >> 5, pc = rem & 31; wv[p] = *(const GAS v4u*)(rwh + (size_t)hl * (48 * 2048) + (size_t)n * D + 256 * (c_) + 8 * pc); } } while (0)
        P6_WLOAD(0);
        P6_XLOAD(0, 0);
#pragma unroll 1
        for (int c2 = 0; c2 < 8; c2 += 2)
#pragma unroll
        for (int ci = 0; ci < 2; ++ci) { const int c = c2 + ci;
            P6_BAR();
            {
#pragma unroll
              for (int p = 0; p < 6; ++p) { const int idx = F.tid + 512 * p, hl = idx / 1536, rem = idx % 1536, n = rem >> 5, pc = rem & 31; *(LAS v4u*)(WL + hl * 25344 + n * 528 + pc * 16) = wv[p]; }
              if (c + 1 < 8) { P6_WLOAD(c + 1); P6_XLOAD(c + 1, ci ^ 1); } }
            P6_BAR();
#pragma unroll
            for (int kk = 0; kk < 4; ++kk) {
                const int kl = 128 * kh + 32 * kk + 8 * g, k0 = 256 * c + kl;
                const f32x4 a = xa[ci][kk], cc = xc[ci][kk];
                const f32x4 u0 = a * rstd * *(const LAS f32x4*)(sg + k0) + *(const LAS f32x4*)(sh + k0), u1 = cc * rstd * *(const LAS f32x4*)(sg + k0 + 4) + *(const LAS f32x4*)(sh + k0 + 4);
                v4u hi; hi.x = cvt_pk_bf16s(u0.x, u0.y); hi.y = cvt_pk_bf16s(u0.z, u0.w); hi.z = cvt_pk_bf16s(u1.x, u1.y); hi.w = cvt_pk_bf16s(u1.z, u1.w);
                v4u lo; lo.x = cvt_pk_bf16s(u0.x - bflo(hi.x), u0.y - bfhi(hi.x)); lo.y = cvt_pk_bf16s(u0.z - bflo(hi.y), u0.w - bfhi(hi.y)); lo.z = cvt_pk_bf16s(u1.x - bflo(hi.z), u1.y - bfhi(hi.z)); lo.w = cvt_pk_bf16s(u1.z - bflo(hi.w), u1.w - bfhi(hi.w));
                { v2u q8; q8.x = pk4_fp8(u0.x, u0.y, u0.z, u0.w); q8.y = pk4_fp8(u1.x, u1.y, u1.z, u1.w); *(GAS v2u*)(ur + k0) = q8; }
                const bf16x8 ah = __builtin_bit_cast(bf16x8, hi), al = __builtin_bit_cast(bf16x8, lo);
#pragma unroll
                for (int nt = 0; nt < 3; ++nt) { const bf16x8 bh = *(const LAS bf16x8*)(WL + (nt * 16 + l15) * 528 + kl * 2), bl = *(const LAS bf16x8*)(WL + 25344 + (nt * 16 + l15) * 528 + kl * 2);
                    acc[nt] = __builtin_amdgcn_mfma_f32_16x16x32_bf16(ah, bh, acc[nt], 0, 0, 0); acc[nt] = __builtin_amdgcn_mfma_f32_16x16x32_bf16(ah, bl, acc[nt], 0, 0, 0); acc[nt] = __builtin_amdgcn_mfma_f32_16x16x32_bf16(al, bh, acc[nt], 0, 0, 0); }
            }
        }
#undef P6_XLOAD
#undef P6_WLOAD
#undef P6_BAR
#pragma unroll
        for (int nt = 0; nt < 3; ++nt)
#pragma unroll
            for (int r = 0; r < 4; ++r) LG[(w * 16 + 4 * g + r) * 48 + nt * 16 + l15] = acc[nt][r];
        __syncthreads();
        if (kh == 0 && lane < 16) {
            LAS float* q0 = LG + (w * 16 + lane) * 48; const LAS float* q1 = LG + ((w + 1) * 16 + lane) * 48; const int tok = rb * 64 + rg * 16 + lane;
            for (int i = 0; i < 36; ++i) q0[i] = q0[i] + q1[i] + (i < 32 ? F.re_b[i] : F.rg_b[i - 32]);
            int gs = 0; float gm = q0[32];
            for (int gg = 1; gg < 4; ++gg) if (q0[32 + gg] > gm) { gm = q0[32 + gg]; gs = gg; }
            float gden = 0.f; for (int gg = 0; gg < 4; ++gg) gden += __expf(q0[32 + gg] - gm);
            const float pg = 1.f / gden;
            const LAS float* le = q0 + gs * 8;
            int i0 = 0; float m0 = le[0];
            for (int i = 1; i < 8; ++i) if (le[i] > m0) { m0 = le[i]; i0 = i; }
            int i1 = (i0 + 1) & 7; float m1 = -3.0e38f;
            for (int i = 0; i < 8; ++i) if (i != i0 && le[i] > m1) { m1 = le[i]; i1 = i; }
            const float e1 = __expf(m1 - m0), wt0 = pg / (1.f + e1), wt1 = pg * e1 / (1.f + e1);
            F.tokw[tok * 2] = wt0; F.tokw[tok * 2 + 1] = wt1;
            const int ea = gs * 8 + i0, eb = gs * 8 + i1;
            const int pa = __hip_atomic_fetch_add(HI + ea, 1, __ATOMIC_RELAXED, __HIP_MEMORY_SCOPE_WORKGROUP); F.list[(rb * 32 + ea) * 64 + pa] = tok * 2;
            const int pb = __hip_atomic_fetch_add(HI + eb, 1, __ATOMIC_RELAXED, __HIP_MEMORY_SCOPE_WORKGROUP); F.list[(rb * 32 + eb) * 64 + pb] = tok * 2 + 1;
        }
        __syncthreads();
        if (F.tid < 32) F.cntw[rb * 32 + F.tid] = HI[F.tid];
    }
}
constexpr int PRE_OFF = PRE_OFF_;
__device__ __forceinline__ void moe_table(Frame& F) {
    volatile LAS int* tab = (volatile LAS int*)(F.lds + TAB_OFF);
    LAS unsigned short* PRE = (LAS unsigned short*)(F.lds + PRE_OFF);
    LAS int* SEG = (LAS int*)(F.lds + PRE_OFF + 16384);
    __syncthreads();
    const int e = F.tid & 31, seg = F.tid >> 5;
    int c[16]; int ssum = 0;
#pragma unroll
    for (int i = 0; i < 16; ++i) { c[i] = ((const GAS int*)F.cntw)[(seg * 16 + i) * 32 + e]; }
#pragma unroll
    for (int i = 0; i < 16; ++i) ssum += c[i];
    SEG[seg * 32 + e] = ssum;
    __syncthreads();
    int off = 0, tot = 0;
#pragma unroll
    for (int q = 0; q < 16; ++q) { const int z = SEG[q * 32 + e]; off += (q < seg) ? z : 0; tot += z; }
#pragma unroll
    for (int i = 0; i < 16; ++i) { PRE[e * 256 + seg * 16 + i] = (unsigned short)off; off += c[i]; }
    if (seg == 0) tab[e] = tot;
    __syncthreads();
    if (F.tid == 0) { int base = 0;
        for (int k = 0; k < 32; ++k) { tab[32 + k] = base; base += (tab[k] + 255) >> 8; }
        tab[64] = base; }
    __syncthreads();
}
__device__ __forceinline__ void p9_phase(Frame& F) {
    LAS float* gf = (LAS float*)F.lds; LAS float* fg = gf + 2048;
    const float* rowf = (const float*)F.row;
    for (int rb = F.vcu; rb < 256; rb += F.G) {
        const int b = rb >> 5;
        __syncthreads();
        for (int k = F.tid; k < 2048; k += 512) { gf[k] = F.modf[b * 12288 + 5 * D + k]; fg[k] = F.fin_g[k]; }
        __syncthreads();
        for (int r2 = 0; r2 < 8; r2 += 2) {
            f32x4 hv[2][8]; v2u ya[2][8], yc[2][8]; float w0[2], w1[2];
#pragma unroll
            for (int q = 0; q < 2; ++q) { const int row = rb * 64 + F.wave * 8 + r2 + q;
                const GAS f32x4* hr = (const GAS f32x4*)(F.out + (size_t)row * D) + F.lane;
                const GAS v2u* y0 = (const GAS v2u*)(F.row + (size_t)row * RB + S_Y0) + F.lane; const GAS v2u* y1 = (const GAS v2u*)(F.row + (size_t)row * RB + S_Y1) + F.lane;
                w0[q] = F.tokw[row * 2]; w1[q] = F.tokw[row * 2 + 1];
#pragma unroll
                for (int j = 0; j < 8; ++j) { hv[q][j] = hr[64 * j]; ya[q][j] = y0[64 * j]; yc[q][j] = y1[64 * j]; } }
            __builtin_amdgcn_sched_barrier(0);
#pragma unroll
            for (int q = 0; q < 2; ++q) { const int row = rb * 64 + F.wave * 8 + r2 + q; float s = 0.f;
#pragma unroll
                for (int j = 0; j < 8; ++j) { const v2u a = ya[q][j], c = yc[q][j]; const f32x4 g4 = *(const LAS f32x4*)(gf + 4 * (F.lane + 64 * j));
                    const f32x4 f = {w0[q] * bflo(a.x) + w1[q] * bflo(c.x), w0[q] * bfhi(a.x) + w1[q] * bfhi(c.x), w0[q] * bflo(a.y) + w1[q] * bflo(c.y), w0[q] * bfhi(a.y) + w1[q] * bfhi(c.y)};
                    hv[q][j] = hv[q][j] + g4 * f; s += (hv[q][j].x * hv[q][j].x + hv[q][j].y * hv[q][j].y) + (hv[q][j].z * hv[q][j].z + hv[q][j].w * hv[q][j].w); }
                const float rstd = rsqrtf(wave_sum(s) * (1.f / D) + 1e-6f);
                GAS f32x4* op = (GAS f32x4*)(F.out + (size_t)row * D) + F.lane;
#pragma unroll
                for (int j = 0; j < 8; ++j) op[64 * j] = hv[q][j] * rstd * *(const LAS f32x4*)(fg + 4 * (F.lane + 64 * j)); }
        }
    }
}

struct Args { const void* in[21]; float* out; unsigned char* ws; int ph_lo, ph_hi; };
__global__ void __launch_bounds__(512, 2) mk_fwd(Args args) {
    extern __shared__ __attribute__((aligned(16))) unsigned char lds[];
    Frame F;
    F.lds = (LAS unsigned char*)lds;
    F.MISC = (volatile LAS unsigned*)(F.lds + MISC_OFF);
    F.tid = threadIdx.x; F.lane = F.tid & 63; F.wave = __builtin_amdgcn_readfirstlane(F.tid >> 6);
    F.G = gridDim.x; { const int bx = blockIdx.x; F.vcu = (F.G % 8 == 0) ? (bx % 8) * (F.G / 8) + bx / 8 : bx; }
    unsigned char* ws = args.ws; F.ws = ws;
    F.ctl = (gu32*)(ws + WS_CTL);
    F.x = (const float*)args.in[0]; F.c = (const float*)args.in[1]; F.pos = (const int*)args.in[2]; F.ada_w = (const float*)args.in[3]; F.ada_b = (const float*)args.in[4];
    F.mix_g = (const float*)args.in[5]; F.w_in = (const float*)args.in[6]; F.w_a = (const float*)args.in[7]; F.w_r = (const float*)args.in[8]; F.w_o = (const float*)args.in[9];
    F.rec_g = (const float*)args.in[10]; F.lbl = (const float*)args.in[11]; F.ffn_g = (const float*)args.in[12]; F.rg_w = (const float*)args.in[13]; F.rg_b = (const float*)args.in[14];
    F.re_w = (const float*)args.in[15]; F.re_b = (const float*)args.in[16]; F.e_gate = (const float*)args.in[17]; F.e_up = (const float*)args.in[18]; F.e_down = (const float*)args.in[19];
    F.fin_g = (const float*)args.in[20]; F.out = args.out;
    F.modp = (float*)(ws + WS_MODP); F.modf = (float*)(ws + WS_MODF); F.lb = (float*)(ws + WS_LB); F.rwt = (float*)(ws + WS_RWT); F.tokw = (float*)(ws + WS_TOKW); F.list = (int*)(ws + WS_LIST); F.cntw = (int*)(ws + WS_CNTW);
    F.win_t = (bf16*)(ws + WS_WIN); F.wa_t = (bf16*)(ws + WS_WA); F.wr_t = (bf16*)(ws + WS_WR); F.wo_t = (bf16*)(ws + WS_WO); F.w1_t = (bf16*)(ws + WS_W1); F.w2_t = (bf16*)(ws + WS_W2);
    F.U = (bf16*)(ws + WS_U); F.hdn = (bf16*)(ws + WS_U); F.row = (bf16*)(ws + WS_ROW);
    for (int u = F.tid; u < (LDS_BYTES - LDSCTL_OFF) / 4; u += 512) ((LAS unsigned*)(F.lds + LDSCTL_OFF))[u] = 0u;
    __syncthreads();
    XcdBarrier bar; bar.bar = (unsigned*)(F.ctl + CW_BAR); bar.x = 0; bar.st = nullptr;
    if (MK_N_LAUNCHES == 1) bar = xcd_barrier_post((unsigned*)(F.ctl + CW_BAR), F.MISC + 8);
#define GRID_BAR(seam) do { if (MK_N_LAUNCHES != 1) { if (F.tid == 0) __hip_atomic_store(F.ctl + CW_TMO, 0xBADBA0u | (unsigned)(seam), RLX_AGENT); } else { xcd_barrier(bar); } } while (0)
    const int lo = args.ph_lo, hi = args.ph_hi;
#define IN(k) (lo <= (k) && (k) < hi)
#define BOTH(k) (IN(k) && IN((k) + 1))

    if (IN(0)) { p0_phase(F); if (BOTH(0)) GRID_BAR(0); }
    if (IN(1)) { p1_phase(F); if (BOTH(1)) GRID_BAR(1); }
    if (IN(2)) {
        pg8::DenseOrder S; S.init(F.U, F.ws + WS_WIN8, D / 2, D / 2, T, RB, F.G, (int)blockIdx.x);
        EpiProj E{F.row, F.pos, (bf16*)F.out, (const float*)(F.ws + WS_USC), (const float*)(F.ws + WS_WSC), (LAS float*)(F.lds + 131072)};
        pg8::gemm_phase<EpiProj, pg8::DenseOrder, false, 2>(F.lds, D / 2, D / 2, S, E);
        if (BOTH(2)) GRID_BAR(2);
    }
    if (IN(3)) { p3_phase(F); if (BOTH(3)) GRID_BAR(3); }
    if (IN(4)) {
        { pg8::DenseOrder S; if (F8_SQ & 1) S.init(F.ws + WS_YA8, F.wa_t, D / 2, D / 2, T, D, F.G, (int)blockIdx.x); else S.init(F.row + S_YA, F.wa_t, RB, D, T, D, F.G, (int)blockIdx.x); EpiGate<0> E{F.row};
          pg8::gemm_phase<EpiGate<0>, pg8::DenseOrder, false, (F8_SQ & 1) ? 1 : 0>(F.lds, (F8_SQ & 1) ? D / 2 : D, (F8_SQ & 1) ? D / 2 : RB, S, E); }
        { pg8::DenseOrder S; if (F8_SQ & 2) S.init(F.ws + WS_YR8, F.wr_t, D / 2, D / 2, T, D, F.G, (int)blockIdx.x); else S.init(F.row + S_YR, F.wr_t, RB, D, T, D, F.G, (int)blockIdx.x); EpiGate<1> E{F.row};
          pg8::gemm_phase<EpiGate<1>, pg8::DenseOrder, false, (F8_SQ & 2) ? 1 : 0>(F.lds, (F8_SQ & 2) ? D / 2 : D, (F8_SQ & 2) ? D / 2 : RB, S, E); }
        if (BOTH(4)) GRID_BAR(4);
    }
    if (IN(5)) {
        pg8::DenseOrder S; S.init(F.row + ((F8_SQ & 4) ? S_VA : S_MG), F.wo_t, RB, (F8_SQ & 4) ? D / 2 : D, T, D, F.G, (int)blockIdx.x); EpiH E{F.modf, F.x, F.out, (float*)(F.ws + WS_PSUM), (LAS float*)(F.lds + 131072)};
        pg8::gemm_phase<EpiH, pg8::DenseOrder, false, (F8_SQ & 4) ? 1 : 0>(F.lds, (F8_SQ & 4) ? D / 2 : D, RB, S, E);
        if (BOTH(5)) GRID_BAR(5);
    }
    if (IN(6)) { p6_phase(F); if (BOTH(6)) GRID_BAR(6); }
    if (IN(7)) {
        moe_table(F);
        const int units_ = ((const LAS int*)(F.lds + TAB_OFF))[64] * 8, rnds_ = (units_ + F.G - 1) / F.G + 1, NG = rnds_ > 0 ? (units_ + rnds_ - 1) / rnds_ : 1;
        pg8::MoeOrder S{(const LAS int*)(F.lds + TAB_OFF), (const LAS unsigned short*)(F.lds + PRE_OFF), (const char*)(F.row + S_U2), (const char*)F.w1_t, (size_t)D * D, RB, D / 2, F.list, NG, F.vcu, true, nullptr};
        EpiSwiGLU E{F.hdn};
        if (F.vcu < NG) pg8::gemm_phase<EpiSwiGLU, pg8::MoeOrder, true, 1>(F.lds, D / 2, RB, S, E);
        convert_queue<true>(F, CW_QUEUE + 192, 1024, 1536);
        if (BOTH(7)) GRID_BAR(7);
    }
    if (IN(8)) {
        moe_table(F);
        pg8::MoeOrder S{(const LAS int*)(F.lds + TAB_OFF), (const LAS unsigned short*)(F.lds + PRE_OFF), (const char*)F.hdn, (const char*)F.w2_t, (size_t)D * EH, EH / 2, EH / 2, F.list, F.G, F.vcu, false, (LAS int*)(F.lds + PRE_OFF + 16384 + 2048)};
        EpiScatter E{F.row, F.list, (const LAS unsigned short*)(F.lds + PRE_OFF), (const LAS int*)(F.lds + PRE_OFF + 16384 + 2048)};
        pg8::gemm_phase<EpiScatter, pg8::MoeOrder, false, 1>(F.lds, EH / 2, EH / 2, S, E);
        if (BOTH(8)) GRID_BAR(8);
    }
    if (IN(9)) { p9_phase(F); }
#undef IN
#undef BOTH
}

extern "C" void kernel_launch(void* const* d_in, const int* in_sizes, int n_in, void* d_out, int out_size, void* d_ws, size_t ws_size, hipStream_t stream) {
    static int grid = 0;
    if (grid == 0) {
        if (n_in != 21 || out_size != T * D || ws_size < WS_END) { fprintf(stderr, "kernel_launch: unexpected shapes: n_in %d out %d ws %zu (need %zu)\n", n_in, out_size, ws_size, (size_t)WS_END); grid = -1; return; }
        int dev = 0, cus = 0, per_cu = 0;
        if (hipGetDevice(&dev) != hipSuccess || hipDeviceGetAttribute(&cus, hipDeviceAttributeMultiprocessorCount, dev) != hipSuccess) { grid = -1; return; }
        if (hipFuncSetAttribute((const void*)mk_fwd, hipFuncAttributeMaxDynamicSharedMemorySize, LDS_BYTES) != hipSuccess) { fprintf(stderr, "kernel_launch: hipFuncSetAttribute failed\n"); grid = -1; return; }
        if (hipOccupancyMaxActiveBlocksPerMultiprocessor(&per_cu, (const void*)mk_fwd, 512, LDS_BYTES) != hipSuccess || per_cu < 1) fprintf(stderr, "kernel_launch: occupancy query reports %d\n", per_cu);
        (void)hipGetLastError();
        grid = cus;
    }
    if (grid < 0) return;
    if (hipMemsetAsync((char*)d_ws + WS_CTL, 0, CTL_ZERO_BYTES, stream) != hipSuccess) return;
    Args a{};
    for (int i = 0; i < 21; ++i) a.in[i] = d_in[i];
    a.out = (float*)d_out; a.ws = (unsigned char*)d_ws;
    if (MK_N_LAUNCHES == 1) { a.ph_lo = 0; a.ph_hi = NPHASE; hipLaunchKernelGGL(mk_fwd, dim3(grid), dim3(512), LDS_BYTES, stream, a); }
    else for (int p = 0; p < NPHASE; ++p) { a.ph_lo = p; a.ph_hi = p + 1; hipLaunchKernelGGL(mk_fwd, dim3(grid), dim3(512), LDS_BYTES, stream, a); }
}
```
